# Optimizing an MI355X kernel written in HIP

```python
import jax, jax.numpy as jnp
from jax import lax
import numpy as np

D_MODEL = 2048
BATCH = 2
SEQ = 4096
DEPTH = 1

RMS_EPS = 1e-6
ROPE_THETA = 10000.0
MIX_WIDTH = D_MODEL
HG_WIDTH = MIX_WIDTH // 2
HG_DK = 128
HG_DV = 128
HG_HEADS = HG_WIDTH // HG_DV
HG_CHUNK = 64
NSA_WIDTH = MIX_WIDTH - HG_WIDTH
NSA_DH = 64
NSA_HEADS = NSA_WIDTH // NSA_DH
NSA_KV = 2
NSA_REP = NSA_HEADS // NSA_KV
CMP_LEN = 32
CMP_STRIDE = 16
CMP_HIDDEN = 256
SEL_LEN = 64
SEL_TOP = 16
WINDOW = 512
Q_BLOCK = 128
MEM_LEN = 256
X_HEADS = 4
X_DH = 128
D_FF = ((8 * D_MODEL // 3) + 255) // 256 * 256
IN_SIZES = (HG_HEADS * HG_DK, HG_HEADS * HG_DK, HG_WIDTH, HG_WIDTH,
            NSA_WIDTH,
            NSA_KV * NSA_DH, NSA_KV * NSA_DH,
            NSA_KV * NSA_DH, NSA_KV * NSA_DH,
            NSA_KV * NSA_DH, NSA_KV * NSA_DH,
            NSA_HEADS * 3)
D_IN = sum(IN_SIZES)

kernel_name = "hybrid_hgrn2_nsa_macaron_layer"


def rmsnorm(x, w):
    xf = x.astype(jnp.float32)
    y = xf * lax.rsqrt(jnp.mean(xf * xf, axis=-1, keepdims=True) + RMS_EPS)
    return (y * w.astype(jnp.float32)).astype(x.dtype)


def swiglu(h, w_gate, w_up, w_down):
    return (jax.nn.silu(h @ w_gate) * (h @ w_up)) @ w_down


def rope(t, positions):
    half = t.shape[-1] // 2
    inv = ROPE_THETA ** (-jnp.arange(half, dtype=jnp.float32) / half)
    ang = positions.astype(jnp.float32)[..., None] * inv
    cos, sin = jnp.cos(ang)[:, :, None, :], jnp.sin(ang)[:, :, None, :]
    tf = t.astype(jnp.float32)
    t1, t2 = tf[..., :half], tf[..., half:]
    return jnp.concatenate([t1 * cos - t2 * sin, t2 * cos + t1 * sin], axis=-1).astype(t.dtype)


def masked_softmax(s, mask):
    s = jnp.where(mask, s.astype(jnp.float32), -jnp.inf)
    m = jnp.max(s, axis=-1, keepdims=True)
    m = jnp.where(jnp.isfinite(m), m, 0.0)
    e = jnp.where(mask, jnp.exp(s - m), 0.0)
    return e / jnp.maximum(jnp.sum(e, axis=-1, keepdims=True), 1e-30)


def hgrn2_mix(q, f_logit, i, g, lb, norm_w):
    B, S = q.shape[:2]
    nc = S // HG_CHUNK
    lb = lb.reshape(HG_HEADS, HG_DK)
    f = lb + (1.0 - lb) * jax.nn.sigmoid(f_logit.astype(jnp.float32))
    logf = jnp.log(f)
    k = 1.0 - f

    def chunks(t, d):
        return t.astype(jnp.float32).reshape(B, nc, HG_CHUNK, HG_HEADS, d).transpose(1, 0, 3, 2, 4)

    causal = jnp.tril(jnp.ones((HG_CHUNK, HG_CHUNK), dtype=bool))[:, :, None]

    def step(state, inp):
        qc, kc, lfc, vc = inp
        b = jnp.cumsum(lfc, axis=2)
        o_inter = jnp.einsum('bhck,bhkv->bhcv', qc * jnp.exp(b), state)
        diff = b[:, :, :, None, :] - b[:, :, None, :, :]
        decay = jnp.exp(jnp.where(causal, diff, -jnp.inf))
        att = jnp.einsum('bhtk,bhsk,bhtsk->bhts', qc, kc, decay)
        o_intra = jnp.einsum('bhts,bhsv->bhtv', att, vc)
        b_last = b[:, :, -1:, :]
        new_state = jnp.exp(b_last[:, :, 0, :])[..., None] * state + \
            jnp.einsum('bhsk,bhsv->bhkv', kc * jnp.exp(b_last - b), vc)
        return new_state, o_inter + o_intra

    state0 = jnp.zeros((B, HG_HEADS, HG_DK, HG_DV), jnp.float32)
    _, o = lax.scan(step, state0, (chunks(q, HG_DK), chunks(k, HG_DK), chunks(logf, HG_DK), chunks(i, HG_DV)))
    o = o.transpose(1, 0, 3, 2, 4).reshape(B, S, HG_HEADS, HG_DV)
    o = o * lax.rsqrt(jnp.mean(o * o, axis=-1, keepdims=True) + RMS_EPS)
    o = o.reshape(B, S, HG_WIDTH) * norm_w.astype(jnp.float32) * jax.nn.silu(g.astype(jnp.float32))
    return o.astype(q.dtype)


def nsa_mix(q, kc_tok, vc_tok, ks, vs, kw, vw, gate_logits, pe, ck_w1, ck_w2, cv_w1, cv_w2):
    B, S = q.shape[:2]
    G, R, dh = NSA_KV, NSA_REP, NSA_DH
    scale = dh ** -0.5
    n_cmp = (S - CMP_LEN) // CMP_STRIDE + 1
    n_sel = S // SEL_LEN
    n_top = min(SEL_TOP, n_sel)
    n_qb = S // Q_BLOCK

    cidx = jnp.arange(n_cmp)[:, None] * CMP_STRIDE + jnp.arange(CMP_LEN)[None, :]

    def compress(tok, w1, w2):
        blocks = tok[:, cidx] + pe[None, None, :, None, :]
        blocks = blocks.transpose(0, 1, 3, 2, 4).reshape(B, n_cmp, G, CMP_LEN * dh)
        return (jax.nn.silu(blocks @ w1) @ w2).transpose(0, 2, 1, 3)

    kc = compress(kc_tok, ck_w1, ck_w2)
    vc = compress(vc_tok, cv_w1, cv_w2)
    c_start = jnp.arange(n_cmp) * CMP_STRIDE
    cmp_end = c_start + CMP_LEN - 1
    s_start = jnp.arange(n_sel) * SEL_LEN
    overlap = jnp.clip(jnp.minimum(c_start[:, None] + CMP_LEN, s_start[None, :] + SEL_LEN)
                       - jnp.maximum(c_start[:, None], s_start[None, :]), 0, None).astype(jnp.float32) / CMP_LEN

    to_bg = lambda t: t.transpose(0, 2, 1, 3)
    ksb = to_bg(ks).reshape(B, G, n_sel, SEL_LEN, dh)
    vsb = to_bg(vs).reshape(B, G, n_sel, SEL_LEN, dh)
    kw_pad = jnp.pad(to_bg(kw), ((0, 0), (0, 0), (WINDOW, 0), (0, 0)))
    vw_pad = jnp.pad(to_bg(vw), ((0, 0), (0, 0), (WINDOW, 0), (0, 0)))
    qg = q.reshape(B, S, G, R, dh).transpose(0, 2, 3, 1, 4)
    bidx = jnp.arange(B)[:, None, None, None]
    gidx = jnp.arange(G)[None, :, None, None]
    blk_ids = jnp.arange(n_sel)

    def block(qb_i):
        q0 = qb_i * Q_BLOCK
        qb = lax.dynamic_slice_in_dim(qg, q0, Q_BLOCK, axis=3)
        tpos = q0 + jnp.arange(Q_BLOCK)
        s_c = jnp.einsum('bgrqd,bgnd->bgrqn', qb, kc) * scale
        p_c = masked_softmax(s_c, cmp_end[None, :] <= tpos[:, None])
        o_c = jnp.einsum('bgrqn,bgnd->bgrqd', p_c.astype(vc.dtype), vc)
        imp = jnp.einsum('bgrqn,nj->bgqj', p_c, overlap)
        cur = tpos // SEL_LEN
        forced = (blk_ids[None, :] == 0) | (blk_ids[None, :] == cur[:, None]) | (blk_ids[None, :] == cur[:, None] - 1)
        future = blk_ids[None, :] > cur[:, None]
        score = jnp.where(forced, jnp.inf, jnp.where(future, -jnp.inf, imp))
        _, sel = lax.top_k(score, n_top)
        k_sel = ksb[bidx, gidx, sel]
        v_sel = vsb[bidx, gidx, sel].reshape(B, G, Q_BLOCK, n_top * SEL_LEN, dh)
        tok = sel[..., None] * SEL_LEN + jnp.arange(SEL_LEN)
        mask_s = (tok <= tpos[None, None, :, None, None]).reshape(B, G, 1, Q_BLOCK, n_top * SEL_LEN)
        s_s = jnp.einsum('bgrqd,bgqntd->bgrqnt', qb, k_sel).reshape(B, G, R, Q_BLOCK, n_top * SEL_LEN) * scale
        p_s = masked_softmax(s_s, mask_s)
        o_s = jnp.einsum('bgrqm,bgqmd->bgrqd', p_s.astype(v_sel.dtype), v_sel)
        kwb = lax.dynamic_slice_in_dim(kw_pad, q0, Q_BLOCK + WINDOW, axis=2)
        vwb = lax.dynamic_slice_in_dim(vw_pad, q0, Q_BLOCK + WINDOW, axis=2)
        kpos = q0 - WINDOW + jnp.arange(Q_BLOCK + WINDOW)
        dpos = tpos[:, None] - kpos[None, :]
        mask_w = (dpos >= 0) & (dpos < WINDOW) & (kpos[None, :] >= 0)
        s_w = jnp.einsum('bgrqd,bgkd->bgrqk', qb, kwb) * scale
        p_w = masked_softmax(s_w, mask_w)
        o_w = jnp.einsum('bgrqk,bgkd->bgrqd', p_w.astype(vwb.dtype), vwb)
        return jnp.stack([o_c, o_s, o_w], axis=0)

    outs = lax.map(block, jnp.arange(n_qb))
    outs = outs.transpose(1, 2, 0, 5, 3, 4, 6).reshape(3, B, S, NSA_HEADS, dh)
    gates = jax.nn.sigmoid(gate_logits.reshape(B, S, NSA_HEADS, 3)).transpose(3, 0, 1, 2)[..., None]
    o = jnp.sum(gates.astype(outs.dtype) * outs, axis=0)
    return o.reshape(B, S, NSA_WIDTH)


def mem_cross_attn(h, m, wq, wk, wv, wo):
    B, S, _ = h.shape
    M = m.shape[1]
    q = (h @ wq).reshape(B, S, X_HEADS, X_DH)
    k = (m @ wk).reshape(B, M, X_HEADS, X_DH)
    v = (m @ wv).reshape(B, M, X_HEADS, X_DH)
    s = jnp.einsum('bshd,bmhd->bhsm', q, k) * (X_DH ** -0.5)
    p = jax.nn.softmax(s.astype(jnp.float32), axis=-1).astype(v.dtype)
    o = jnp.einsum('bhsm,bmhd->bshd', p, v).reshape(B, S, X_HEADS * X_DH)
    return o @ wo


def setup_inputs(seed: int = 0) -> dict:
    key = jax.random.key(seed)
    k = jax.random.split(key, 30)
    f32 = jnp.float32
    L = DEPTH

    def w(kk, shape, fan_in):
        return jax.random.normal(kk, shape, f32) * fan_in ** -0.5

    def gain(kk, shape):
        return 1.0 + 0.01 * jax.random.normal(kk, shape, f32)

    x = jax.random.normal(k[0], (BATCH, SEQ, D_MODEL), f32)
    mem = jax.random.normal(k[1], (BATCH, MEM_LEN, D_MODEL), f32)
    positions = (jax.random.randint(k[2], (BATCH, 1), 0, 1024, dtype=jnp.int32)
                 + jnp.arange(SEQ, dtype=jnp.int32)[None, :]).astype(jnp.int32)
    return {
        'x': x, 'mem': mem, 'positions': positions,
        'ffn1_norm': gain(k[3], (L, D_MODEL)),
        'ffn1_w_gate': w(k[4], (L, D_MODEL, D_FF), D_MODEL),
        'ffn1_w_up': w(k[5], (L, D_MODEL, D_FF), D_MODEL),
        'ffn1_w_down': w(k[6], (L, D_FF, D_MODEL), D_FF),
        'mix_norm': gain(k[7], (L, D_MODEL)),
        'w_in': w(k[8], (L, D_MODEL, D_IN), D_MODEL),
        'hgrn_lb_logits': 0.5 * jax.random.normal(k[9], (L + 1, HG_HEADS * HG_DK), f32),
        'hgrn_out_norm': gain(k[10], (L, HG_WIDTH)),
        'nsa_cmp_pe': 0.1 * jax.random.normal(k[11], (L, CMP_LEN, NSA_DH), f32),
        'nsa_cmp_k_w1': w(k[12], (L, CMP_LEN * NSA_DH, CMP_HIDDEN), CMP_LEN * NSA_DH),
        'nsa_cmp_k_w2': w(k[13], (L, CMP_HIDDEN, NSA_DH), CMP_HIDDEN),
        'nsa_cmp_v_w1': w(k[14], (L, CMP_LEN * NSA_DH, CMP_HIDDEN), CMP_LEN * NSA_DH),
        'nsa_cmp_v_w2': w(k[15], (L, CMP_HIDDEN, NSA_DH), CMP_HIDDEN),
        'w_out': w(k[16], (L, MIX_WIDTH, D_MODEL), MIX_WIDTH),
        'xattn_norm': gain(k[17], (L, D_MODEL)),
        'mem_norm': gain(k[18], (L, D_MODEL)),
        'xattn_wq': w(k[19], (L, D_MODEL, X_HEADS * X_DH), D_MODEL),
        'xattn_wk': w(k[20], (L, D_MODEL, X_HEADS * X_DH), D_MODEL),
        'xattn_wv': w(k[21], (L, D_MODEL, X_HEADS * X_DH), D_MODEL),
        'xattn_wo': w(k[22], (L, X_HEADS * X_DH, D_MODEL), X_HEADS * X_DH),
        'ffn2_norm': gain(k[23], (L, D_MODEL)),
        'ffn2_w_gate': w(k[24], (L, D_MODEL, D_FF), D_MODEL),
        'ffn2_w_up': w(k[25], (L, D_MODEL, D_FF), D_MODEL),
        'ffn2_w_down': w(k[26], (L, D_FF, D_MODEL), D_FF),
        'final_norm': gain(k[27], (D_MODEL,)),
    }


def reference(x, mem, positions, ffn1_norm, ffn1_w_gate, ffn1_w_up, ffn1_w_down, mix_norm, w_in,
              hgrn_lb_logits, hgrn_out_norm, nsa_cmp_pe, nsa_cmp_k_w1, nsa_cmp_k_w2, nsa_cmp_v_w1,
              nsa_cmp_v_w2, w_out, xattn_norm, mem_norm, xattn_wq, xattn_wk, xattn_wv, xattn_wo,
              ffn2_norm, ffn2_w_gate, ffn2_w_up, ffn2_w_down, final_norm):
    B, S, _ = x.shape
    lb_all = jnp.cumsum(jax.nn.softmax(hgrn_lb_logits.astype(jnp.float32), axis=0), axis=0)
    split_at = [int(v) for v in np.cumsum(IN_SIZES)[:-1]]
    kv_heads = lambda t: t.reshape(B, S, NSA_KV, NSA_DH)
    for l in range(DEPTH):
        x = x + 0.5 * swiglu(rmsnorm(x, ffn1_norm[l]), ffn1_w_gate[l], ffn1_w_up[l], ffn1_w_down[l])
        h = rmsnorm(x, mix_norm[l])
        hq, hf, hi, hg, nq, nkc, nvc, nks, nvs, nkw, nvw, ngate = jnp.split(h @ w_in[l], split_at, axis=-1)
        o_hg = hgrn2_mix(hq.reshape(B, S, HG_HEADS, HG_DK), hf.reshape(B, S, HG_HEADS, HG_DK),
                         hi.reshape(B, S, HG_HEADS, HG_DV), hg, lb_all[l], hgrn_out_norm[l])
        o_nsa = nsa_mix(rope(nq.reshape(B, S, NSA_HEADS, NSA_DH), positions),
                        rope(kv_heads(nkc), positions), kv_heads(nvc),
                        rope(kv_heads(nks), positions), kv_heads(nvs),
                        rope(kv_heads(nkw), positions), kv_heads(nvw), ngate,
                        nsa_cmp_pe[l], nsa_cmp_k_w1[l], nsa_cmp_k_w2[l], nsa_cmp_v_w1[l], nsa_cmp_v_w2[l])
        x = x + jnp.concatenate([o_hg, o_nsa], axis=-1) @ w_out[l]
        x = x + mem_cross_attn(rmsnorm(x, xattn_norm[l]), rmsnorm(mem, mem_norm[l]),
                               xattn_wq[l], xattn_wk[l], xattn_wv[l], xattn_wo[l])
        x = x + 0.5 * swiglu(rmsnorm(x, ffn2_norm[l]), ffn2_w_gate[l], ffn2_w_up[l], ffn2_w_down[l])
    return rmsnorm(x, final_norm)
```

```cpp
#include <hip/hip_runtime.h>
#include <cstdio>
#include <cstdint>
namespace pg8 {
#define PG8_LAS __attribute__((address_space(3)))
typedef unsigned short bf16_t;
typedef short bf16x8 __attribute__((ext_vector_type(8)));
typedef float f32x4 __attribute__((ext_vector_type(4)));
typedef unsigned u32x4 __attribute__((ext_vector_type(4)));
typedef unsigned u32x2 __attribute__((ext_vector_type(2)));
constexpr int BM = 256, BK = 64, HALF = 128, HTB = HALF * BK * 2  , STAGE_BYTES = 8 * HTB, NXCD = 8, WGM = 8;

__host__ __device__ __forceinline__ int lds_byte(int r, int c) { const int st = (r >> 4) * 2 + (c >> 5), rr = r & 15, cc = c & 31, ob = rr * 64 + cc * 2; return st * 1024 + (ob ^ (((ob >> 9) & 1) << 5)); }
__host__ __device__ __forceinline__ void stage_rc(int b, int& R, int& C) { const int st = b / 1024, sb = b % 1024, swz = sb ^ (((sb >> 9) & 1) << 5); R = (st >> 1) * 16 + swz / 64; C = (st & 1) * 32 + (swz % 64) / 2; }
__host__ __device__ __forceinline__ int perm32(int rho) { const int n = rho >> 4, i = rho & 15; return 8 * (i >> 2) + 4 * n + (i & 3); }

struct Unit { int pm, pn; };
struct Gemm { const bf16_t* A; const bf16_t* Bt; int M, N, K; };

struct StaticOrder {
    int nM, nN, nwg, G, c;
    __host__ __device__ void init(int M, int N, int G_, int c_) { nM = M / BM; nN = N / BM; nwg = nM * nN; G = G_; c = c_; }
    __host__ __device__ bool next(int i, Unit& u) const {
        const long L = (long)i * G + c; if (L >= nwg) return false;
        int wgid = (int)L; { const int q = nwg / NXCD, r = nwg % NXCD, xcd = wgid % NXCD, off = wgid / NXCD; wgid = (xcd < r ? xcd * (q + 1) : r * (q + 1) + (xcd - r) * q) + off; }
        const int nig = WGM * nN, gid = wgid / nig, fm = gid * WGM, gsz = (nM - fm) < WGM ? (nM - fm) : WGM;
        u.pm = fm + ((wgid % nig) % gsz); u.pn = (wgid % nig) / gsz; return true;
    }
    __device__ __forceinline__ void a_ready(const Unit&) const {}
    __device__ __forceinline__ void done(const Unit&) const {}
};

__device__ __forceinline__ unsigned cvt_pk_bf16(float lo, float hi) { unsigned r; asm volatile("v_cvt_pk_bf16_f32 %0, %1, %2" : "=v"(r) : "v"(lo), "v"(hi)); return r; }

__device__ __forceinline__ float row_rstd(const float* ssq, int row, int fq) {
    const f32x4* p = (const f32x4*)(ssq + (size_t)row * 32 + 8 * fq);
    const f32x4 a = p[0], b = p[1];
    float s = ((a[0] + a[1]) + (a[2] + a[3])) + ((b[0] + b[1]) + (b[2] + b[3]));
    s += __shfl_xor(s, 16); s += __shfl_xor(s, 32);
    return __builtin_amdgcn_rsqf(s * (1.0f / 2048.0f) + 1e-6f);
}
__device__ __forceinline__ float silu_f(float x) { return x * __builtin_amdgcn_rcpf(1.0f + __expf(-x)); }

struct EpiScaleBf16 {
    static constexpr bool PERM = true, AFTER_DRAIN = false;
    bf16_t* O; int ldc; const float* ssq;
    __device__ __forceinline__ void operator()(const f32x4 (&acc)[2][2][4][2], const Unit& u, int wr, int wc, int fr, int fq) const {
        const int row0 = u.pm * BM + wr * 64 + fr, col0 = u.pn * BM + wc * 32 + 8 * fq;
#pragma unroll
        for (int ai = 0; ai < 2; ++ai)
#pragma unroll
            for (int m = 0; m < 4; ++m) { const int row = row0 + ai * HALF + m * 16; const float rs = ssq ? row_rstd(ssq, row, fq) : 1.0f;
                bf16_t* rowp = O + (size_t)row * ldc + col0;
#pragma unroll
                for (int bj = 0; bj < 2; ++bj) { const f32x4 v0 = acc[ai][bj][m][0] * rs, v1 = acc[ai][bj][m][1] * rs;
                    u32x4 w; w.x = cvt_pk_bf16(v0[0], v0[1]); w.y = cvt_pk_bf16(v0[2], v0[3]); w.z = cvt_pk_bf16(v1[0], v1[1]); w.w = cvt_pk_bf16(v1[2], v1[3]);
                    *(u32x4*)(rowp + bj * HALF) = w; } }
    }
};
struct EpiSwiglu {
    static constexpr bool PERM = true, AFTER_DRAIN = false;
    bf16_t* O; int ldc; const float* ssq;
    __device__ __forceinline__ void operator()(const f32x4 (&acc)[2][2][4][2], const Unit& u, int wr, int wc, int fr, int fq) const {
        const int row0 = u.pm * BM + wr * 64 + fr, col0 = u.pn * HALF + wc * 32 + 8 * fq;
#pragma unroll
        for (int ai = 0; ai < 2; ++ai)
#pragma unroll
            for (int m = 0; m < 4; ++m) { const int row = row0 + ai * HALF + m * 16; const float rs = row_rstd(ssq, row, fq);
                const f32x4 g0 = acc[ai][0][m][0] * rs, g1 = acc[ai][0][m][1] * rs, u0 = acc[ai][1][m][0] * rs, u1 = acc[ai][1][m][1] * rs;
                f32x4 a0, a1;
#pragma unroll
                for (int i = 0; i < 4; ++i) { a0[i] = silu_f(g0[i]) * u0[i]; a1[i] = silu_f(g1[i]) * u1[i]; }
                u32x4 w; w.x = cvt_pk_bf16(a0[0], a0[1]); w.y = cvt_pk_bf16(a0[2], a0[3]); w.z = cvt_pk_bf16(a1[0], a1[1]); w.w = cvt_pk_bf16(a1[2], a1[3]);
                *(u32x4*)(O + (size_t)row * ldc + col0) = w; }
    }
};
struct EpiResid {
    static constexpr bool PERM = false, AFTER_DRAIN = false;
    const float* base; float* out; bf16_t* xb; float* ssq_out; float scale;
    __device__ __forceinline__ void operator()(const f32x4 (&acc)[2][2][4][2], const Unit& u, int wr, int wc, int fr, int fq) const {
        const int row0 = u.pm * BM + wr * 64 + fr, col0 = u.pn * BM + wc * 32 + 4 * fq;
#pragma unroll
        for (int ai = 0; ai < 2; ++ai)
#pragma unroll
            for (int m = 0; m < 4; ++m) { const int row = row0 + ai * HALF + m * 16; const size_t off = (size_t)row * 2048 + col0; float ss = 0.f;
#pragma unroll
                for (int bj = 0; bj < 2; ++bj)
#pragma unroll
                    for (int n = 0; n < 2; ++n) { const size_t c = off + bj * HALF + n * 16; const f32x4 b = *(const f32x4*)(base + c); const f32x4 v = b + acc[ai][bj][m][n] * scale;
                        *(f32x4*)(out + c) = v; ss += (v[0] * v[0] + v[1] * v[1]) + (v[2] * v[2] + v[3] * v[3]);
                        if (xb) { u32x2 w; w.x = cvt_pk_bf16(v[0], v[1]); w.y = cvt_pk_bf16(v[2], v[3]); *(u32x2*)(xb + c) = w; } }
                ss += __shfl_xor(ss, 16); ss += __shfl_xor(ss, 32);
                if (fq == 0) ssq_out[(size_t)row * 32 + u.pn * 4 + wc] = ss; }
    }
};

template <class Epi, class Sched, bool ALIGN_EPI = false, bool SP2 = false>
__device__ __forceinline__ void gemm_phase(PG8_LAS unsigned char* lds, const Gemm g, const Sched& S, const Epi& E) {
    int tid_ = threadIdx.x; asm volatile("" : "+v"(tid_));
    const int tid = tid_, wid = __builtin_amdgcn_readfirstlane(tid >> 6), lane = tid & 63, wr = wid >> 2, wc = wid & 3, fr = lane & 15, fq = lane >> 4;
    const int K = g.K, nt = K / BK;
    unsigned voffA[2], voffB[2];
#pragma unroll
    for (int i = 0; i < 2; ++i) { int R, C; stage_rc(tid * 16 + i * 8192, R, C); const int Rb = Epi::PERM ? ((R & ~31) + perm32(R & 31)) : R;
        voffA[i] = (unsigned)(R * K + C) * 2u; voffB[i] = (unsigned)(Rb * K + C) * 2u; }
    const size_t kstep = (size_t)(BK * 2);
    const size_t hstep = (size_t)HALF * K * 2;
    const size_t tstep = 2 * hstep;
    const unsigned ldsw = (unsigned)wid * 1024u;
    const int aoff = lds_byte(wr * 64 + fr, fq * 8), boff = lds_byte(wc * 32 + fr, fq * 8);
#define PG8_SA(b, h) (((b) * 2 + (h)) * HTB)
#define PG8_SB(b, h) ((4 + (b) * 2 + (h)) * HTB)
#define PG8_STAGE(bufoff, gbase, voff) do { _Pragma("unroll") for (int _i = 0; _i < 2; ++_i) \
        __builtin_amdgcn_global_load_lds((const unsigned*)((const char*)(gbase) + (voff)[_i]), (PG8_LAS unsigned*)(lds + (bufoff) + ldsw + _i * 8192), 16, 0, 0); } while (0)
#define PG8_LDA(dst, b, h) do { _Pragma("unroll") for (int m = 0; m < 4; ++m) _Pragma("unroll") for (int k = 0; k < 2; ++k) dst[m][k] = *(const PG8_LAS bf16x8*)(lds + PG8_SA(b, h) + aoff + m * 2048 + k * 1024); } while (0)
#define PG8_LDB(dst, b, h) do { _Pragma("unroll") for (int n = 0; n < 2; ++n) _Pragma("unroll") for (int k = 0; k < 2; ++k) dst[n][k] = *(const PG8_LAS bf16x8*)(lds + PG8_SB(b, h) + boff + n * 2048 + k * 1024); } while (0)
#define PG8_MMA(ai, bj, At, Bt) do { __builtin_amdgcn_s_setprio(1); _Pragma("unroll") for (int m = 0; m < 4; ++m) _Pragma("unroll") for (int n = 0; n < 2; ++n) _Pragma("unroll") for (int k = 0; k < 2; ++k) \
        acc[ai][bj][m][n] = __builtin_amdgcn_mfma_f32_16x16x32_bf16(Bt[n][k], At[m][k], acc[ai][bj][m][n], 0, 0, 0); __builtin_amdgcn_s_setprio(0); } while (0)
#define PG8_WAIT_V(n) asm volatile("s_waitcnt vmcnt(" #n ")" ::: "memory")
#define PG8_WAIT_L(n) asm volatile("s_waitcnt lgkmcnt(" #n ")" ::: "memory")
#define PG8_BAR __builtin_amdgcn_s_barrier()
#define PG8_SCHED __builtin_amdgcn_sched_barrier(0)
    Unit cur, nxt; int ui = 0;
    if (!S.next(0, cur)) return;
    f32x4 acc[2][2][4][2];
#pragma unroll
    for (int a = 0; a < 2; ++a)
#pragma unroll
        for (int b = 0; b < 2; ++b)
#pragma unroll
            for (int m = 0; m < 4; ++m)
#pragma unroll
                for (int n = 0; n < 2; ++n) acc[a][b][m][n] = (f32x4){0.f, 0.f, 0.f, 0.f};
    bf16x8 At[4][2], B0[2][2], B1[2][2];
    const char* cA = (const char*)g.A + (size_t)cur.pm * tstep; const char* cB = (const char*)g.Bt + (size_t)cur.pn * tstep;
    S.a_ready(cur);
    if constexpr (SP2) {
        PG8_STAGE(PG8_SB(0, 0), cB, voffB); PG8_STAGE(PG8_SB(0, 1), cB + hstep, voffB); PG8_STAGE(PG8_SA(0, 0), cA, voffA); PG8_STAGE(PG8_SA(0, 1), cA + hstep, voffA);
        if (wr == 1) PG8_BAR;
        PG8_WAIT_V(2); PG8_BAR;
        PG8_STAGE(PG8_SB(1, 0), cB + kstep, voffB); PG8_STAGE(PG8_SA(1, 0), cA + kstep, voffA); PG8_STAGE(PG8_SB(1, 1), cB + hstep + kstep, voffB);
        PG8_WAIT_V(6); PG8_BAR;
    } else {
        PG8_STAGE(PG8_SB(0, 0), cB, voffB); PG8_STAGE(PG8_SA(0, 0), cA, voffA); PG8_STAGE(PG8_SB(0, 1), cB + hstep, voffB); PG8_STAGE(PG8_SA(0, 1), cA + hstep, voffA);
        if (wr == 1) PG8_BAR;
        PG8_WAIT_V(4); PG8_BAR;
        PG8_STAGE(PG8_SB(1, 0), cB + kstep, voffB); PG8_STAGE(PG8_SA(1, 0), cA + kstep, voffA); PG8_STAGE(PG8_SB(1, 1), cB + hstep + kstep, voffB);
        PG8_WAIT_V(6); PG8_BAR;
    }
    for (;;) {
        const bool has_next = S.next(ui + 1, nxt);
        const char* nA = has_next ? (const char*)g.A + (size_t)nxt.pm * tstep : cA; const char* nB = has_next ? (const char*)g.Bt + (size_t)nxt.pn * tstep : cB;
        for (int t = 0; t < nt; t += 2) {
            const bool last = (t == nt - 2);
            const char* a1 = cA + (size_t)(t + 1) * kstep;
            const char* a2 = last ? nA : cA + (size_t)(t + 2) * kstep; const char* b2 = last ? nB : cB + (size_t)(t + 2) * kstep;
            const char* a3 = a2 + kstep; const char* b3 = b2 + kstep;
            if (last && has_next) S.a_ready(nxt);
            if constexpr (SP2) {
            PG8_LDB(B0, 0, 0); PG8_LDB(B1, 0, 1); PG8_SCHED; PG8_LDA(At, 0, 0); PG8_STAGE(PG8_SA(1, 1), a1 + hstep, voffA);
            PG8_WAIT_V(8); PG8_WAIT_L(0); PG8_BAR; PG8_MMA(0, 0, At, B0); PG8_MMA(0, 1, At, B1); PG8_BAR; PG8_SCHED;
            PG8_LDA(At, 0, 1); PG8_STAGE(PG8_SB(0, 0), b2, voffB); PG8_STAGE(PG8_SB(0, 1), b2 + hstep, voffB); PG8_STAGE(PG8_SA(0, 0), a2, voffA);
            PG8_WAIT_V(8); PG8_WAIT_L(0); PG8_BAR; PG8_MMA(1, 0, At, B0); PG8_MMA(1, 1, At, B1); PG8_BAR; PG8_SCHED;
            PG8_LDB(B0, 1, 0); PG8_LDB(B1, 1, 1); PG8_SCHED; PG8_LDA(At, 1, 0); PG8_STAGE(PG8_SA(0, 1), a2 + hstep, voffA);
            PG8_WAIT_V(8); PG8_WAIT_L(0); PG8_BAR; PG8_MMA(0, 0, At, B0); PG8_MMA(0, 1, At, B1); PG8_BAR; PG8_SCHED;
            PG8_LDA(At, 1, 1); PG8_STAGE(PG8_SB(1, 0), b3, voffB); PG8_STAGE(PG8_SB(1, 1), b3 + hstep, voffB); PG8_STAGE(PG8_SA(1, 0), a3, voffA);
            PG8_WAIT_V(8); PG8_WAIT_L(0); PG8_BAR; PG8_MMA(1, 0, At, B0); PG8_MMA(1, 1, At, B1); PG8_BAR; PG8_SCHED;
            } else {
            PG8_LDB(B0, 0, 0); PG8_SCHED; PG8_LDA(At, 0, 0); PG8_STAGE(PG8_SA(1, 1), a1 + hstep, voffA);
            PG8_WAIT_L(8); PG8_BAR; PG8_WAIT_L(0); PG8_MMA(0, 0, At, B0); PG8_BAR; PG8_SCHED;
            PG8_LDB(B1, 0, 1); PG8_STAGE(PG8_SB(0, 0), b2, voffB);
            PG8_BAR; PG8_WAIT_L(0); PG8_MMA(0, 1, At, B1); PG8_BAR;
            PG8_LDA(At, 0, 1); PG8_STAGE(PG8_SA(0, 0), a2, voffA);
            PG8_BAR; PG8_WAIT_L(0); PG8_MMA(1, 0, At, B0); PG8_BAR; PG8_SCHED;
            PG8_STAGE(PG8_SB(0, 1), b2 + hstep, voffB);
            PG8_WAIT_V(6); PG8_BAR; PG8_MMA(1, 1, At, B1); PG8_BAR;
            PG8_LDB(B0, 1, 0); PG8_SCHED; PG8_LDA(At, 1, 0); PG8_STAGE(PG8_SA(0, 1), a2 + hstep, voffA);
            PG8_WAIT_L(8); PG8_BAR; PG8_WAIT_L(0); PG8_MMA(0, 0, At, B0); PG8_BAR; PG8_SCHED;
            PG8_LDB(B1, 1, 1); PG8_STAGE(PG8_SB(1, 0), b3, voffB);
            PG8_BAR; PG8_WAIT_L(0); PG8_MMA(0, 1, At, B1); PG8_BAR;
            PG8_LDA(At, 1, 1); PG8_STAGE(PG8_SA(1, 0), a3, voffA);
            PG8_BAR; PG8_WAIT_L(0); PG8_MMA(1, 0, At, B0); PG8_BAR; PG8_SCHED;
            PG8_STAGE(PG8_SB(1, 1), b3 + hstep, voffB);
            PG8_WAIT_V(6); PG8_BAR; PG8_MMA(1, 1, At, B1); PG8_BAR;
            }
        }
        if constexpr (ALIGN_EPI) { if (wr == 0) PG8_BAR; }
        if constexpr (!Epi::AFTER_DRAIN) { E(acc, cur, wr, wc, fr, fq); S.done(cur); }
        if (!has_next) break;
#pragma unroll
        for (int a = 0; a < 2; ++a)
#pragma unroll
            for (int b = 0; b < 2; ++b)
#pragma unroll
                for (int m = 0; m < 4; ++m)
#pragma unroll
                    for (int n = 0; n < 2; ++n) acc[a][b][m][n] = (f32x4){0.f, 0.f, 0.f, 0.f};
        cur = nxt; cA = nA; cB = nB; ++ui;
        if constexpr (ALIGN_EPI) { if (wr == 1) PG8_BAR; }
    }
    PG8_WAIT_V(0);
    if constexpr (!ALIGN_EPI) { if (wr == 0) PG8_BAR; }
    PG8_BAR;
    if constexpr (Epi::AFTER_DRAIN) { E.fused(acc, cur, wr, wc, fr, fq, lds, wid, lane); S.done(cur); }
#undef PG8_SA
#undef PG8_SB
#undef PG8_STAGE
#undef PG8_LDA
#undef PG8_LDB
#undef PG8_MMA
#undef PG8_WAIT_V
#undef PG8_WAIT_L
#undef PG8_BAR
#undef PG8_SCHED
}
}
#define GAS __attribute__((address_space(1)))
#define LAS __attribute__((address_space(3)))
typedef unsigned short bf16;
typedef unsigned v4u __attribute__((ext_vector_type(4)));
typedef float f32x4 __attribute__((ext_vector_type(4)));
typedef short bf16x8 __attribute__((ext_vector_type(8)));
typedef GAS unsigned gu32;
typedef GAS unsigned long long gu64;
#define RLX_AGENT __ATOMIC_RELAXED, __HIP_MEMORY_SCOPE_AGENT
#define LDS_WAIT() asm volatile("s_waitcnt lgkmcnt(0)" ::: "memory")
#define VM_WAIT() asm volatile("s_waitcnt vmcnt(0)" ::: "memory")
__device__ __forceinline__ unsigned long long rt() { return __builtin_amdgcn_s_memrealtime(); }
__device__ __forceinline__ unsigned f2bf(float f) { unsigned u = __builtin_bit_cast(unsigned, f); return (u + 0x7fffu + ((u >> 16) & 1u)) >> 16; }
__device__ __forceinline__ unsigned pk2(float lo, float hi) { return f2bf(lo) | (f2bf(hi) << 16); }

#define XB_TMO      128
#define XB_XCNT(j)  (256  + 64 * (j))
#define XB_XSUB(j)  (1280 + 64 * (j))
#define XB_XGEN(j)  (2304 + 64 * (j))
#define XB_TOP      3328
#define XB_TOPGEN   3392
#define XCD_BAR_WORDS 3456
#define XB_SPIN_CAP (1u << 18)

__device__ __forceinline__ unsigned xb_ld(unsigned* p)              { return __hip_atomic_load(p, __ATOMIC_RELAXED, __HIP_MEMORY_SCOPE_AGENT); }
__device__ __forceinline__ unsigned xb_add(unsigned* p, unsigned v) { return __hip_atomic_fetch_add(p, v, __ATOMIC_RELAXED, __HIP_MEMORY_SCOPE_AGENT); }
__device__ __forceinline__ unsigned xb_xcc_id() { return (unsigned)__builtin_amdgcn_s_getreg((3 << 11) | 20) & 0xFu; }
#define XB_SPIN(cond, bar) do { unsigned _sp = 0; while (cond) { __builtin_amdgcn_s_sleep(1); \
    if ((++_sp & 255u) == 0u) { if (xb_ld(&(bar)[XB_TMO])) break; if (_sp > XB_SPIN_CAP) { atomicAdd(&(bar)[XB_TMO], 1u); break; } } } } while (0)

struct XcdBarrier {
    unsigned* bar; unsigned x;
    volatile LAS unsigned* st;
};

__device__ __forceinline__ XcdBarrier xcd_barrier_post(unsigned* bar, volatile LAS unsigned* st) {
    XcdBarrier b; b.bar = bar; b.x = xb_xcc_id(); b.st = st;
    if (threadIdx.x == 0) (void)xb_add(&bar[XB_XCNT(b.x)], 1u);
    return b;
}
__device__ __forceinline__ void xcd_barrier_complete(unsigned* bar, unsigned x, unsigned& nloc, unsigned& nx) {
    const unsigned G = gridDim.x * gridDim.y * gridDim.z;
    unsigned sum, cnt, mine, sp = 0u;
    for (;;) {
        sum = 0u; cnt = 0u; mine = 0u;
#pragma unroll
        for (unsigned j = 0; j < 16; ++j) { const unsigned c = xb_ld(&bar[XB_XCNT(j)]); sum += c; cnt += (c > 0u) ? 1u : 0u; mine = (j == x) ? c : mine; }
        if (sum == G) break;
        __builtin_amdgcn_s_sleep(1);
        if ((++sp & 255u) == 0u) { if (xb_ld(&bar[XB_TMO])) break; if (sp > XB_SPIN_CAP) { atomicAdd(&bar[XB_TMO], 1u); break; } }
    }
    nloc = mine > 0u ? mine : 1u; nx = cnt > 0u ? cnt : 1u;
}

__device__ __forceinline__ void xcd_barrier(const XcdBarrier& b) {
    asm volatile("s_waitcnt vmcnt(0)" ::: "memory");
    __syncthreads();
    if (threadIdx.x == 0) {
        unsigned* bar = b.bar;
        __builtin_amdgcn_s_waitcnt(0);
        unsigned nloc = b.st[0], nx = b.st[1];
        if (nloc == 0u) { xcd_barrier_complete(bar, b.x, nloc, nx); b.st[0] = nloc; b.st[1] = nx; }
        const unsigned old = xb_add(&bar[XB_XSUB(b.x)], 1u);
        const unsigned gen = old / nloc;
        if (old + 1u == (gen + 1u) * nloc) {
            __builtin_amdgcn_fence(__ATOMIC_RELEASE, "agent");
            asm volatile("s_waitcnt vmcnt(0)" ::: "memory");
            const unsigned og = xb_add(&bar[XB_TOP], 1u);
            const unsigned tg = og / nx;
            if (og + 1u == (tg + 1u) * nx) xb_add(&bar[XB_TOPGEN], 1u);
            else XB_SPIN(xb_ld(&bar[XB_TOPGEN]) == tg, bar);
            __builtin_amdgcn_fence(__ATOMIC_ACQUIRE, "agent");
            xb_add(&bar[XB_XGEN(b.x)], 1u);
            asm volatile("s_waitcnt vmcnt(0)" ::: "memory");
        } else {
            XB_SPIN(xb_ld(&bar[XB_XGEN(b.x)]) == gen, bar);
            __builtin_amdgcn_fence(__ATOMIC_ACQUIRE, "agent");
            asm volatile("s_waitcnt vmcnt(0)" ::: "memory");
        }
    }
    __syncthreads();
}

constexpr int NTOK = 8192, SEQ = 4096, DM = 2048, FF = 5632, DIN = 5936, DINP = 6144;
constexpr int C_HQ = 0, C_HF = 1024, C_HI = 2048, C_HG = 3072, C_NQ = 4096, C_KC = 5120, C_VC = 5248, C_KS = 5376, C_VS = 5504, C_KW = 5632, C_VW = 5760, C_GATE = 5888;
constexpr int NPH = 15;
#ifndef MK_ONE_LAUNCH
#define MK_ONE_LAUNCH 1
#endif
constexpr int NWAVES = 8;
constexpr size_t MiB = 1u << 20;
constexpr size_t WS_CTL = 0, CTL_ZERO_BYTES = 1 * MiB;
constexpr size_t WS_SSQ = 1 * MiB, WS_COS = 2 * MiB, WS_SIN = 3 * MiB, WS_LB = 4 * MiB, WS_KC = 4 * MiB + 65536, WS_VC = WS_KC + 262144, WS_CMPH = 6 * MiB;
constexpr size_t WS_WGU = 8 * MiB, WS_WD = 52 * MiB, WS_WIN = 74 * MiB, WS_WOUT = 98 * MiB, WS_WQ = 106 * MiB, WS_WKV = 108 * MiB, WS_WO = 112 * MiB;
constexpr size_t WS_XB = 114 * MiB, WS_ACT = 146 * MiB, WS_HGO = 178 * MiB, WS_QR = 210 * MiB, WS_PROJ = 234 * MiB, WS_OMIX = 330 * MiB;
constexpr size_t WS_KCR = 362 * MiB, WS_KSR = 364 * MiB, WS_KWR = 366 * MiB, WS_GATE = 368 * MiB, WS_QX = 370 * MiB, WS_OX = 378 * MiB, WS_KVX = 386 * MiB, WS_MEMN = 387 * MiB, WS_END = 389 * MiB;
constexpr int CW_BAR = 4096;
constexpr int RING_OFF = 0, RING_BYTES = 131072;
constexpr int LDSCTL_OFF = RING_BYTES, MISC_OFF = LDSCTL_OFF + 320;
constexpr int LDS_BYTES = 147456;

#define DI __device__ __forceinline__
DI float bf2f(unsigned short h) { return __uint_as_float((unsigned)h << 16); }
DI float wave_sum(float v) {
#pragma unroll
    for (int o = 1; o < 64; o <<= 1) v += __shfl_xor(v, o);
    return v;
}
DI float wave_max(float v) {
#pragma unroll
    for (int o = 1; o < 64; o <<= 1) v = fmaxf(v, __shfl_xor(v, o));
    return v;
}
using pg8::silu_f;
DI float sigmoid_f(float x) { return 1.0f / (1.0f + __expf(-x)); }

struct Args { const float* in[28]; float* out; unsigned char* ws; int ph_lo, ph_hi; };
typedef const __attribute__((address_space(4))) unsigned char* kaptr_t;
struct AP {
    kaptr_t ka;
    __device__ __forceinline__ const float* in_(int i) const { return *(const float* const __attribute__((address_space(4)))*)(ka + 8 * i); }
    __device__ __forceinline__ float* out_() const { return *(float* const __attribute__((address_space(4)))*)(ka + 8 * 28); }
    __device__ __forceinline__ unsigned char* ws_() const { return *(unsigned char* const __attribute__((address_space(4)))*)(ka + 8 * 29); }
};
__device__ __forceinline__ AP make_ap() { kaptr_t k = (kaptr_t)__builtin_amdgcn_kernarg_segment_ptr(); asm volatile("" : "+s"(k)); AP a; a.ka = k; return a; }

__constant__ float ROPE_INV[32] = {1.000000000e+00f, 7.498942614e-01f, 5.623413324e-01f, 4.216965139e-01f, 3.162277639e-01f, 2.371373773e-01f, 1.778279394e-01f, 1.333521307e-01f, 1.000000015e-01f, 7.498941571e-02f, 5.623413250e-02f, 4.216965288e-02f, 3.162277490e-02f, 2.371373773e-02f, 1.778279431e-02f, 1.333521493e-02f, 9.999999776e-03f, 7.498941850e-03f, 5.623413250e-03f, 4.216964822e-03f, 3.162277630e-03f, 2.371373586e-03f, 1.778279431e-03f, 1.333521446e-03f, 1.000000047e-03f, 7.498942432e-04f, 5.623413017e-04f, 4.216965172e-04f, 3.162277571e-04f, 2.371373703e-04f, 1.778279402e-04f, 1.333521504e-04f};

DI void sincos_acc(float angf, float& c, float& s) {
    const double x = (double)angf;
    const double n = __builtin_rint(x * 0.63661977236758134308);
    double r = __builtin_fma(-n, 1.57079632679489655800, x); r = __builtin_fma(-n, 6.12323399573676603587e-17, r);
    const int q = ((int)n) & 3;
    const double r2 = r * r;
    const double sp = r * (1.0 + r2 * (-1.0 / 6.0 + r2 * (1.0 / 120.0 + r2 * (-1.0 / 5040.0 + r2 * (1.0 / 362880.0 + r2 * (-1.0 / 39916800.0 + r2 * (1.0 / 6227020800.0 + r2 * (-1.0 / 1307674368000.0))))))));
    const double cp = 1.0 + r2 * (-0.5 + r2 * (1.0 / 24.0 + r2 * (-1.0 / 720.0 + r2 * (1.0 / 40320.0 + r2 * (-1.0 / 3628800.0 + r2 * (1.0 / 479001600.0 + r2 * (-1.0 / 87178291200.0 + r2 * (1.0 / 20922789888000.0))))))));
    const double sv = (q == 0) ? sp : (q == 1) ? cp : (q == 2) ? -sp : -cp;
    const double cv = (q == 0) ? cp : (q == 1) ? -sp : (q == 2) ? -cp : sp;
    c = (float)cv; s = (float)sv;
}

DI void tr_item(const float* W, int K, int N, bf16* WT, int dst_row0, const float* ks, LAS float* scr, int k0, int n0, int lane) {
    const int n = n0 + (lane & 31); const bool ok = n < N;
#pragma unroll 8
    for (int i = 0; i < 32; ++i) { const int kk = 2 * i + (lane >> 5); float v = ok ? W[(size_t)(k0 + kk) * N + n] : 0.f; if (ks) v *= ks[k0 + kk]; scr[kk * 33 + (lane & 31)] = v; }
    LDS_WAIT(); asm volatile("" ::: "memory");
    const int c = lane & 7;
#pragma unroll
    for (int j = 0; j < 4; ++j) { const int nn = (lane >> 3) + 8 * j; const LAS float* s = scr + (8 * c) * 33 + nn;
        v4u o; o.x = pk2(s[0 * 33], s[1 * 33]); o.y = pk2(s[2 * 33], s[3 * 33]); o.z = pk2(s[4 * 33], s[5 * 33]); o.w = pk2(s[6 * 33], s[7 * 33]);
        *(GAS v4u*)(WT + (size_t)(dst_row0 + nn) * K + k0 + 8 * c) = o; }
    LDS_WAIT(); asm volatile("" ::: "memory");
}
DI bool tr_job(int& r, const float* W, int K, int N, bf16* WT, int mode, int row_off, const float* ks, LAS float* scr, int lane) {
    const int nblk = (N + 31) / 32, nitems = (K / 64) * nblk;
    if (r >= nitems) { r -= nitems; return false; }
    const int kb = r / nblk, nb = r % nblk, n0 = 32 * nb;
    const int dst = (mode == 0) ? row_off + n0 : ((n0 >> 7) * 256 + (n0 & 127) + (mode == 2 ? 128 : 0));
    tr_item(W, K, N, WT, dst, ks, scr, 64 * kb, n0, lane);
    return true;
}
DI void row_to_bf16(const float* xrow, bf16* orow, float* ssq_row, const float* w, int lane) {
    const GAS f32x4* xr = (const GAS f32x4*)xrow + lane;
    f32x4 v[8]; float s = 0.f;
#pragma unroll
    for (int j = 0; j < 8; ++j) { v[j] = xr[64 * j]; s += (v[j].x * v[j].x + v[j].y * v[j].y) + (v[j].z * v[j].z + v[j].w * v[j].w); }
    s = wave_sum(s);
    float rs = 1.f;
    if (w) rs = __builtin_amdgcn_rsqf(s * (1.0f / 2048.0f) + 1e-6f);
    GAS unsigned long long* o8 = (GAS unsigned long long*)orow + lane;
#pragma unroll
    for (int j = 0; j < 8; ++j) { f32x4 t = v[j] * rs; if (w) { const f32x4 wv = ((const GAS f32x4*)w)[lane + 64 * j]; t = t * wv; }
        o8[64 * j] = (unsigned long long)pk2(t.x, t.y) | ((unsigned long long)pk2(t.z, t.w) << 32); }
    if (ssq_row && lane < 32) ssq_row[lane] = (lane == 0) ? s : 0.f;
}

DI void phase_prologue(const AP a, LAS unsigned char* lds, int gw, int NGW, int wave, int lane) {
    unsigned char* ws = a.ws_();
    LAS float* scr = (LAS float*)(lds + RING_OFF + wave * 16384);
    constexpr int I_GU = 32 * 176, I_D = 88 * 64, I_IN = 32 * 186, I_OUT = 32 * 64, I_Q = 32 * 16, I_O = 8 * 64;
    constexpr int NITEMS = 2 * I_GU + I_D + I_IN + I_OUT + 3 * I_Q + I_O;
    for (int it = gw; it < NITEMS; it += NGW) {
        int r = it;
        if (tr_job(r, a.in_(4), DM, FF, (bf16*)(ws + WS_WGU), 1, 0, a.in_(3), scr, lane)) continue;
        if (tr_job(r, a.in_(5), DM, FF, (bf16*)(ws + WS_WGU), 2, 0, a.in_(3), scr, lane)) continue;
        if (tr_job(r, a.in_(6), FF, DM, (bf16*)(ws + WS_WD), 0, 0, nullptr, scr, lane)) continue;
        if (tr_job(r, a.in_(8), DM, DIN, (bf16*)(ws + WS_WIN), 0, 0, a.in_(7), scr, lane)) continue;
        if (tr_job(r, a.in_(16), DM, DM, (bf16*)(ws + WS_WOUT), 0, 0, nullptr, scr, lane)) continue;
        if (tr_job(r, a.in_(19), DM, 512, (bf16*)(ws + WS_WQ), 0, 0, a.in_(17), scr, lane)) continue;
        if (tr_job(r, a.in_(20), DM, 512, (bf16*)(ws + WS_WKV), 0, 0, nullptr, scr, lane)) continue;
        if (tr_job(r, a.in_(21), DM, 512, (bf16*)(ws + WS_WKV), 0, 512, nullptr, scr, lane)) continue;
        tr_job(r, a.in_(22), 512, DM, (bf16*)(ws + WS_WO), 0, 0, nullptr, scr, lane);
    }
    for (int m = gw; m < NTOK; m += NGW) row_to_bf16(a.in_(0) + (size_t)m * DM, (bf16*)(ws + WS_XB) + (size_t)m * DM, (float*)(ws + WS_SSQ) + (size_t)m * 32, nullptr, lane);
    for (int m = gw; m < 512; m += NGW) row_to_bf16(a.in_(1) + (size_t)m * DM, (bf16*)(ws + WS_MEMN) + (size_t)m * DM, nullptr, a.in_(18), lane);
    {
        const int* pos = (const int*)a.in_(2); float* ct = (float*)(ws + WS_COS); float* st = (float*)(ws + WS_SIN);
        for (int it = gw; it < NTOK / 2; it += NGW) { const int tok = 2 * it + (lane >> 5), i = lane & 31;
            const float ang = (float)pos[tok] * ROPE_INV[i]; float c, s; sincos_acc(ang, c, s); ct[tok * 32 + i] = c; st[tok * 32 + i] = s; }
    }
    {
        const float* lg = a.in_(9); float* lb = (float*)(ws + WS_LB);
        for (int it = gw; it < 16; it += NGW) { const int i = it * 64 + lane; lb[i] = 1.0f / (1.0f + expf(lg[1024 + i] - lg[i])); }
    }
}
DI void phase_ffn2_weights(const AP a, LAS unsigned char* lds, int gw, int NGW, int wave, int lane) {
    unsigned char* ws = a.ws_();
    LAS float* scr = (LAS float*)(lds + RING_OFF + wave * 16384 + 4096);
    constexpr int I_GU = 32 * 176, I_D = 88 * 64, NITEMS = 2 * I_GU + I_D;
    for (int it = gw; it < NITEMS; it += NGW) {
        int r = it;
        if (tr_job(r, a.in_(24), DM, FF, (bf16*)(ws + WS_WGU), 1, 0, a.in_(23), scr, lane)) continue;
        if (tr_job(r, a.in_(25), DM, FF, (bf16*)(ws + WS_WGU), 2, 0, a.in_(23), scr, lane)) continue;
        tr_job(r, a.in_(26), FF, DM, (bf16*)(ws + WS_WD), 0, 0, nullptr, scr, lane);
    }
}

DI void phase_postproj(const AP a, int gw, int NGW, int lane) {
    unsigned char* ws = a.ws_();
    const bf16* proj = (const bf16*)(ws + WS_PROJ); const float* ct = (const float*)(ws + WS_COS); const float* st = (const float*)(ws + WS_SIN);
    bf16* qr = (bf16*)(ws + WS_QR); bf16* kcr = (bf16*)(ws + WS_KCR); bf16* ksr = (bf16*)(ws + WS_KSR); bf16* kwr = (bf16*)(ws + WS_KWR); float* gate = (float*)(ws + WS_GATE);
    for (int tok = gw; tok < NTOK; tok += NGW) {
        const bf16* pr = proj + (size_t)tok * DINP;
#pragma unroll
        for (int j = 0; j < 8; ++j) { const int p = lane + 64 * j, head = p >> 5, i = p & 31; const float c = ct[tok * 32 + i], s = st[tok * 32 + i];
            const float x1 = bf2f(pr[C_NQ + head * 64 + i]), x2 = bf2f(pr[C_NQ + head * 64 + i + 32]);
            qr[(size_t)tok * 1024 + head * 64 + i] = (bf16)f2bf(x1 * c - x2 * s); qr[(size_t)tok * 1024 + head * 64 + i + 32] = (bf16)f2bf(x2 * c + x1 * s); }
#pragma unroll
        for (int j = 0; j < 3; ++j) { const int g = lane >> 5, i = lane & 31; const float c = ct[tok * 32 + i], s = st[tok * 32 + i];
            const int src = (j == 0) ? C_KC : (j == 1) ? C_KS : C_KW; bf16* dst = (j == 0) ? kcr : (j == 1) ? ksr : kwr;
            const float x1 = bf2f(pr[src + g * 64 + i]), x2 = bf2f(pr[src + g * 64 + i + 32]);
            dst[(size_t)tok * 128 + g * 64 + i] = (bf16)f2bf(x1 * c - x2 * s); dst[(size_t)tok * 128 + g * 64 + i + 32] = (bf16)f2bf(x2 * c + x1 * s); }
        if (lane < 48) gate[tok * 48 + lane] = sigmoid_f(bf2f(pr[C_GATE + lane]));
    }
}

DI void cmp_hidden_item(const AP a, int it, int lane) {
    unsigned char* ws = a.ws_();
    const int kv = it / 4096, rem = it % 4096, row = rem >> 2, jb = rem & 3, bg = row >> 8, n = row & 255, b = bg >> 1, g = bg & 1, j = jb * 64 + lane;
    float* hid = (float*)(ws + WS_CMPH) + (size_t)kv * 262144 + (size_t)row * 256 + j;
    if (n >= 255) { *hid = 0.f; return; }
    const float* w1 = a.in_(kv ? 14 : 12); const float* pe = a.in_(11);
    const bf16* src = kv ? (const bf16*)(ws + WS_PROJ) + C_VC + g * 64 : (const bf16*)(ws + WS_KCR) + g * 64;
    const size_t pitch = kv ? DINP : 128;
    float acc = 0.f;
    for (int t = 0; t < 32; ++t) { const bf16* sr = src + (size_t)(b * SEQ + 16 * n + t) * pitch;
#pragma unroll 8
        for (int d = 0; d < 64; ++d) acc += (bf2f(sr[d]) + pe[t * 64 + d]) * w1[(size_t)(t * 64 + d) * 256 + j]; }
    *hid = silu_f(acc);
}
DI void hgrn_naive_unit(const AP a, LAS unsigned char* lds, int unit, int wave, int lane) {
    unsigned char* ws = a.ws_();
    const int bh = unit >> 2, vb = unit & 3, b = bh >> 3, h = bh & 7, v = vb * 32 + (lane & 31), kh = lane >> 5;
    const bf16* proj = (const bf16*)(ws + WS_PROJ); const float* lb = (const float*)(ws + WS_LB); float* hgo = (float*)(ws + WS_HGO);
    LAS float* fs = (LAS float*)(lds + RING_OFF + wave * 16384); LAS float* qs = fs + 128;
    const float lb0 = lb[h * 128 + lane], lb1 = lb[h * 128 + lane + 64];
    float S[64];
#pragma unroll
    for (int k = 0; k < 64; ++k) S[k] = 0.f;
    const bf16* pr = proj + (size_t)(b * SEQ) * DINP + h * 128;
    float nf0 = bf2f(pr[C_HF + lane]), nf1 = bf2f(pr[C_HF + lane + 64]), nq0 = bf2f(pr[C_HQ + lane]), nq1 = bf2f(pr[C_HQ + lane + 64]), ni = bf2f(pr[C_HI + v]);
    for (int t = 0; t < SEQ; ++t) {
        const float f0 = lb0 + (1.f - lb0) * sigmoid_f(nf0), f1 = lb1 + (1.f - lb1) * sigmoid_f(nf1), q0 = nq0, q1 = nq1, iv = ni;
        if (t + 1 < SEQ) { const bf16* pn = pr + (size_t)(t + 1) * DINP; nf0 = bf2f(pn[C_HF + lane]); nf1 = bf2f(pn[C_HF + lane + 64]); nq0 = bf2f(pn[C_HQ + lane]); nq1 = bf2f(pn[C_HQ + lane + 64]); ni = bf2f(pn[C_HI + v]); }
        fs[lane] = f0; fs[lane + 64] = f1; qs[lane] = q0; qs[lane + 64] = q1;
        LDS_WAIT(); asm volatile("" ::: "memory");
        float o = 0.f;
#pragma unroll
        for (int k4 = 0; k4 < 16; ++k4) { const f32x4 f = ((const LAS f32x4*)fs)[kh * 16 + k4], q = ((const LAS f32x4*)qs)[kh * 16 + k4];
#pragma unroll
            for (int e = 0; e < 4; ++e) { S[4 * k4 + e] = f[e] * S[4 * k4 + e] + (1.f - f[e]) * iv; o += q[e] * S[4 * k4 + e]; } }
        o += __shfl_xor(o, 32);
        if (kh == 0) hgo[(size_t)(b * SEQ + t) * 1024 + h * 128 + v] = o;
        LDS_WAIT(); asm volatile("" ::: "memory");
    }
}
DI void phase_cmp_out_hgnorm(const AP a, int gw, int NGW, int lane) {
    unsigned char* ws = a.ws_();
    for (int it = gw; it < 2 * 1024; it += NGW) {
        const int kv = it >> 10, row = it & 1023; const float* hid = (const float*)(ws + WS_CMPH) + (size_t)kv * 262144 + (size_t)row * 256; const float* w2 = a.in_(kv ? 15 : 13);
        float acc = 0.f;
        for (int j = 0; j < 256; ++j) acc += hid[j] * w2[j * 64 + lane];
        ((float*)(ws + (kv ? WS_VC : WS_KC)))[row * 64 + lane] = acc;
    }
    const float* hgo = (const float*)(ws + WS_HGO); const bf16* proj = (const bf16*)(ws + WS_PROJ); const float* nw = a.in_(10); bf16* omix = (bf16*)(ws + WS_OMIX);
    for (int it = gw; it < NTOK * 8; it += NGW) {
        const int tok = it >> 3, h = it & 7;
        const float o0 = hgo[(size_t)tok * 1024 + h * 128 + lane], o1 = hgo[(size_t)tok * 1024 + h * 128 + lane + 64];
        const float ss = wave_sum(o0 * o0 + o1 * o1), r = __builtin_amdgcn_rsqf(ss * (1.0f / 128.0f) + 1e-6f);
        const float g0 = bf2f(proj[(size_t)tok * DINP + C_HG + h * 128 + lane]), g1 = bf2f(proj[(size_t)tok * DINP + C_HG + h * 128 + lane + 64]);
        omix[(size_t)tok * DM + h * 128 + lane] = (bf16)f2bf(o0 * r * nw[h * 128 + lane] * silu_f(g0));
        omix[(size_t)tok * DM + h * 128 + lane + 64] = (bf16)f2bf(o1 * r * nw[h * 128 + lane + 64] * silu_f(g1));
    }
}
DI float dot64_bf16(const LAS float* q, const bf16* krow) {
    const GAS v4u* kp = (const GAS v4u*)krow; float s = 0.f;
#pragma unroll
    for (int c = 0; c < 8; ++c) { const v4u w = kp[c]; const f32x4 qa = ((const LAS f32x4*)q)[2 * c], qb = ((const LAS f32x4*)q)[2 * c + 1];
        s += qa[0] * __uint_as_float(w.x << 16) + qa[1] * __uint_as_float(w.x & 0xffff0000u) + qa[2] * __uint_as_float(w.y << 16) + qa[3] * __uint_as_float(w.y & 0xffff0000u)
           + qb[0] * __uint_as_float(w.z << 16) + qb[1] * __uint_as_float(w.z & 0xffff0000u) + qb[2] * __uint_as_float(w.w << 16) + qb[3] * __uint_as_float(w.w & 0xffff0000u); }
    return s;
}
DI void nsa_naive_unit(const AP a, LAS unsigned char* lds, int tokg, int wave, int lane) {
    unsigned char* ws = a.ws_();
    const int tok = tokg >> 1, g = tokg & 1, b = tok >> 12, t = tok & 4095, head = g * 8 + wave, bg = b * 2 + g;
    LAS float* qs = (LAS float*)(lds) + wave * 64; LAS float* P = (LAS float*)(lds + 2048); LAS float* SC = (LAS float*)(lds + 10240) + wave * 1024;
    volatile LAS unsigned* mk = (volatile LAS unsigned*)(lds + 43008);
    const bf16* qr = (const bf16*)(ws + WS_QR); const bf16* ksr = (const bf16*)(ws + WS_KSR); const bf16* kwr = (const bf16*)(ws + WS_KWR); const bf16* proj = (const bf16*)(ws + WS_PROJ);
    const float* kc = (const float*)(ws + WS_KC); const float* vc = (const float*)(ws + WS_VC); const float* gate = (const float*)(ws + WS_GATE) + (size_t)tok * 48 + head * 3;
    qs[lane] = bf2f(qr[(size_t)tok * 1024 + head * 64 + lane]);
    LDS_WAIT(); asm volatile("" ::: "memory");
    int nvis = (t >= 31) ? ((t - 31) / 16 + 1) : 0; if (nvis > 255) nvis = 255;
    float sc[4]; float m = -INFINITY;
#pragma unroll
    for (int i = 0; i < 4; ++i) { const int n = lane + 64 * i; float s = -INFINITY;
        if (n < nvis) { const float* kr = kc + (size_t)(bg * 256 + n) * 64; s = 0.f; for (int d = 0; d < 64; ++d) s += qs[d] * kr[d]; s *= 0.125f; }
        sc[i] = s; m = fmaxf(m, s); }
    m = wave_max(m);
    float es = 0.f;
#pragma unroll
    for (int i = 0; i < 4; ++i) { const int n = lane + 64 * i; sc[i] = (n < nvis) ? __expf(sc[i] - m) : 0.f; es += sc[i]; }
    es = wave_sum(es);
    const float inv = 1.0f / fmaxf(es, 1e-30f);
#pragma unroll
    for (int i = 0; i < 4; ++i) P[wave * 256 + lane + 64 * i] = sc[i] * inv;
    LDS_WAIT(); asm volatile("" ::: "memory");
    float oc = 0.f;
    for (int n = 0; n < nvis; ++n) oc += P[wave * 256 + n] * vc[(size_t)(bg * 256 + n) * 64 + lane];
    float accout = gate[0] * oc;
    __syncthreads();
    if (wave == 0) {
        const int j = lane; float imp = 0.f;
        for (int ww = 0; ww < 8; ++ww) { const LAS float* Pw = P + ww * 256; imp += Pw[4 * j] + Pw[4 * j + 1] + Pw[4 * j + 2] + 0.5f * Pw[4 * j + 3] + (j > 0 ? 0.5f * Pw[4 * j - 1] : 0.f); }
        const int cur = t >> 6; const bool forced = (j == 0) || (j == cur) || (j == cur - 1), future = j > cur;
        const float score = forced ? INFINITY : (future ? -INFINITY : imp);
        int rank = 0;
        for (int i = 0; i < 64; ++i) { const float si = __shfl(score, i); rank += (si > score || (si == score && i < j)) ? 1 : 0; }
        const unsigned long long mask = __ballot(rank < 16);
        if (lane == 0) { mk[0] = (unsigned)mask; mk[1] = (unsigned)(mask >> 32); }
    }
    __syncthreads();
    const unsigned long long mask = (unsigned long long)mk[0] | ((unsigned long long)mk[1] << 32);
    {
        int idx = 0; float m2 = -INFINITY;
        for (int j = 0; j < 64; ++j) if ((mask >> j) & 1ull) { const int key = 64 * j + lane; float s = -INFINITY;
            if (key <= t) s = 0.125f * dot64_bf16(qs, ksr + (size_t)(b * SEQ + key) * 128 + g * 64);
            SC[idx * 64 + lane] = s; m2 = fmaxf(m2, s); ++idx; }
        m2 = wave_max(m2);
        float e2 = 0.f;
        for (int i = 0; i < 16; ++i) { const float e = __expf(SC[i * 64 + lane] - m2); SC[i * 64 + lane] = e; e2 += e; }
        e2 = wave_sum(e2);
        LDS_WAIT(); asm volatile("" ::: "memory");
        float os = 0.f; idx = 0;
        for (int j = 0; j < 64; ++j) if ((mask >> j) & 1ull) { const bf16* vr = proj + (size_t)(b * SEQ + 64 * j) * DINP + C_VS + g * 64 + lane;
            for (int kk = 0; kk < 64; ++kk) os += SC[idx * 64 + kk] * bf2f(vr[(size_t)kk * DINP]);
            ++idx; }
        accout += gate[1] * os / fmaxf(e2, 1e-30f);
    }
    {
        float m3 = -INFINITY;
        for (int i = 0; i < 8; ++i) { const int key = t - 511 + i * 64 + lane; float s = -INFINITY;
            if (key >= 0) s = 0.125f * dot64_bf16(qs, kwr + (size_t)(b * SEQ + key) * 128 + g * 64);
            SC[i * 64 + lane] = s; m3 = fmaxf(m3, s); }
        m3 = wave_max(m3);
        float e3 = 0.f;
        for (int i = 0; i < 8; ++i) { const float e = __expf(SC[i * 64 + lane] - m3); SC[i * 64 + lane] = e; e3 += e; }
        e3 = wave_sum(e3);
        LDS_WAIT(); asm volatile("" ::: "memory");
        float ow = 0.f;
        for (int i = 0; i < 512; ++i) { const int key = t - 511 + i; if (key >= 0) ow += SC[i] * bf2f(proj[(size_t)(b * SEQ + key) * DINP + C_VW + g * 64 + lane]); }
        accout += gate[2] * ow / fmaxf(e3, 1e-30f);
    }
    ((bf16*)(ws + WS_OMIX))[(size_t)tok * DM + 1024 + head * 64 + lane] = (bf16)f2bf(accout);
    __syncthreads();
}
DI void xattn_naive_item(const AP a, LAS unsigned char* lds, int it, int wave, int lane) {
    unsigned char* ws = a.ws_();
    const int tok = it >> 2, head = it & 3, b = tok >> 12;
    LAS float* qs = (LAS float*)(lds + RING_OFF + wave * 16384); LAS float* P = qs + 128;
    const bf16* qx = (const bf16*)(ws + WS_QX); const bf16* kvx = (const bf16*)(ws + WS_KVX);
    qs[lane] = bf2f(qx[(size_t)tok * 512 + head * 128 + lane]); qs[lane + 64] = bf2f(qx[(size_t)tok * 512 + head * 128 + lane + 64]);
    LDS_WAIT(); asm volatile("" ::: "memory");
    float sc[4]; float m = -INFINITY;
#pragma unroll
    for (int i = 0; i < 4; ++i) { const int key = lane + 64 * i; const bf16* kr = kvx + (size_t)(b * 256 + key) * 1024 + head * 128;
        const float s = (dot64_bf16(qs, kr) + dot64_bf16(qs + 64, kr + 64)) * 0.08838834764831845f; sc[i] = s; m = fmaxf(m, s); }
    m = wave_max(m);
    float es = 0.f;
#pragma unroll
    for (int i = 0; i < 4; ++i) { sc[i] = __expf(sc[i] - m); es += sc[i]; }
    es = wave_sum(es);
    const float inv = 1.0f / es;
#pragma unroll
    for (int i = 0; i < 4; ++i) P[lane + 64 * i] = sc[i] * inv;
    LDS_WAIT(); asm volatile("" ::: "memory");
    float o0 = 0.f, o1 = 0.f;
    for (int key = 0; key < 256; ++key) { const bf16* vr = kvx + (size_t)(b * 256 + key) * 1024 + 512 + head * 128; const float p = P[key]; o0 += p * bf2f(vr[lane]); o1 += p * bf2f(vr[lane + 64]); }
    bf16* ox = (bf16*)(ws + WS_OX);
    ox[(size_t)tok * 512 + head * 128 + lane] = (bf16)f2bf(o0); ox[(size_t)tok * 512 + head * 128 + lane + 64] = (bf16)f2bf(o1);
    LDS_WAIT(); asm volatile("" ::: "memory");
}
DI void phase_final_norm(const AP a, int gw, int NGW, int lane) {
    const float* ssq = (const float*)(a.ws_() + WS_SSQ); const float* w = a.in_(27);
    for (int m = gw; m < NTOK; m += NGW) {
        const f32x4* sp = (const f32x4*)(ssq + (size_t)m * 32); float s = 0.f;
#pragma unroll
        for (int j = 0; j < 8; ++j) { const f32x4 v = sp[j]; s += (v[0] + v[1]) + (v[2] + v[3]); }
        const float rs = __builtin_amdgcn_rsqf(s * (1.0f / 2048.0f) + 1e-6f);
        GAS f32x4* xr = (GAS f32x4*)(a.out_() + (size_t)m * DM) + lane;
#pragma unroll
        for (int j = 0; j < 8; ++j) { const f32x4 wv = ((const GAS f32x4*)w)[lane + 64 * j]; xr[64 * j] = xr[64 * j] * rs * wv; }
    }
}

__global__ void __launch_bounds__(NWAVES * 64, 2) mega(Args args) {
    extern __shared__ __attribute__((aligned(16))) unsigned char lds_raw[];
    LAS unsigned char* lds = (LAS unsigned char*)lds_raw;
    volatile LAS unsigned* MISC = (volatile LAS unsigned*)(lds + MISC_OFF);
    const int tid = threadIdx.x, lane = tid & 63, wave = __builtin_amdgcn_readfirstlane(tid >> 6);
    const int G = gridDim.x, bid = blockIdx.x;
    const int gw = bid * NWAVES + wave, NGW = G * NWAVES;
    for (int u = tid; u < (LDS_BYTES - LDSCTL_OFF) / 4; u += NWAVES * 64) ((LAS unsigned*)(lds + LDSCTL_OFF))[u] = 0u;
    __syncthreads();
    const int lo = args.ph_lo, hi = args.ph_hi;
    XcdBarrier bar; bar.bar = (unsigned*)(args.ws + WS_CTL) + CW_BAR; bar.x = 0; bar.st = nullptr;
    if (hi - lo > 1) bar = xcd_barrier_post((unsigned*)(args.ws + WS_CTL) + CW_BAR, MISC + 8);
#define IN(k) (lo <= (k) && (k) < hi)
#define SEAM(k) do { if (IN(k) && IN((k) + 1)) xcd_barrier(bar); } while (0)
#define GEMM_RUN(EPI, g, S, E) pg8::gemm_phase<EPI, pg8::StaticOrder, true, true>(lds + RING_OFF, g, S, E)

    if (IN(0)) { const AP a = make_ap(); phase_prologue(a, lds, gw, NGW, wave, lane); }
    SEAM(0);
    if (IN(1)) {
        const AP a = make_ap(); unsigned char* ws = a.ws_();
        pg8::Gemm g{(const bf16*)(ws + WS_XB), (const bf16*)(ws + WS_WGU), NTOK, 2 * FF, DM}; pg8::StaticOrder S; S.init(NTOK, 2 * FF, G, bid);
        pg8::EpiSwiglu E{(bf16*)(ws + WS_ACT), FF, (const float*)(ws + WS_SSQ)};
        GEMM_RUN(pg8::EpiSwiglu, g, S, E);
    }
    SEAM(1);
    if (IN(2)) {
        const AP a = make_ap(); unsigned char* ws = a.ws_();
        pg8::Gemm g{(const bf16*)(ws + WS_ACT), (const bf16*)(ws + WS_WD), NTOK, DM, FF}; pg8::StaticOrder S; S.init(NTOK, DM, G, bid);
        pg8::EpiResid E{a.in_(0), a.out_(), (bf16*)(ws + WS_XB), (float*)(ws + WS_SSQ), 0.5f};
        GEMM_RUN(pg8::EpiResid, g, S, E);
    }
    SEAM(2);
    if (IN(3)) {
        const AP a = make_ap(); unsigned char* ws = a.ws_();
        pg8::Gemm g{(const bf16*)(ws + WS_XB), (const bf16*)(ws + WS_WIN), NTOK, DINP, DM}; pg8::StaticOrder S; S.init(NTOK, DINP, G, bid);
        pg8::EpiScaleBf16 E{(bf16*)(ws + WS_PROJ), DINP, (const float*)(ws + WS_SSQ)};
        GEMM_RUN(pg8::EpiScaleBf16, g, S, E);
    }
    SEAM(3);
    if (IN(4)) { const AP a = make_ap(); phase_postproj(a, gw, NGW, lane); }
    SEAM(4);
    if (IN(5)) {
        const AP a = make_ap();
        if (wave == 0) { if (bid < 64) hgrn_naive_unit(a, lds, bid, wave, lane); }
        else { const int cw = bid * 7 + (wave - 1), NCW = G * 7; for (int it = cw; it < 8192; it += NCW) cmp_hidden_item(a, it, lane); }
    }
    SEAM(5);
    if (IN(6)) { const AP a = make_ap(); phase_cmp_out_hgnorm(a, gw, NGW, lane); }
    SEAM(6);
    if (IN(7)) { const AP a = make_ap(); for (int u = bid; u < NTOK * 2; u += G) nsa_naive_unit(a, lds, u, wave, lane); }
    SEAM(7);
    if (IN(8)) {
        const AP a = make_ap(); unsigned char* ws = a.ws_();
        pg8::Gemm g{(const bf16*)(ws + WS_OMIX), (const bf16*)(ws + WS_WOUT), NTOK, DM, DM}; pg8::StaticOrder S; S.init(NTOK, DM, G, bid);
        pg8::EpiResid E{a.out_(), a.out_(), (bf16*)(ws + WS_XB), (float*)(ws + WS_SSQ), 1.0f};
        GEMM_RUN(pg8::EpiResid, g, S, E);
    }
    SEAM(8);
    if (IN(9)) {
        { const AP a = make_ap(); unsigned char* ws = a.ws_();
          pg8::Gemm g{(const bf16*)(ws + WS_XB), (const bf16*)(ws + WS_WQ), NTOK, 512, DM}; pg8::StaticOrder S; S.init(NTOK, 512, G, bid);
          pg8::EpiScaleBf16 E{(bf16*)(ws + WS_QX), 512, (const float*)(ws + WS_SSQ)};
          GEMM_RUN(pg8::EpiScaleBf16, g, S, E); }
        { const AP a = make_ap(); unsigned char* ws = a.ws_();
          pg8::Gemm g{(const bf16*)(ws + WS_MEMN), (const bf16*)(ws + WS_WKV), 512, 1024, DM}; pg8::StaticOrder S; S.init(512, 1024, G, (bid + G - 64) % G);
          pg8::EpiScaleBf16 E{(bf16*)(ws + WS_KVX), 1024, nullptr};
          GEMM_RUN(pg8::EpiScaleBf16, g, S, E); }
    }
    SEAM(9);
    if (IN(10)) {
        const AP a = make_ap();
        for (int it = gw; it < NTOK * 4; it += NGW) xattn_naive_item(a, lds, it, wave, lane);
        phase_ffn2_weights(a, lds, gw, NGW, wave, lane);
    }
    SEAM(10);
    if (IN(11)) {
        const AP a = make_ap(); unsigned char* ws = a.ws_();
        pg8::Gemm g{(const bf16*)(ws + WS_OX), (const bf16*)(ws + WS_WO), NTOK, DM, 512}; pg8::StaticOrder S; S.init(NTOK, DM, G, bid);
        pg8::EpiResid E{a.out_(), a.out_(), (bf16*)(ws + WS_XB), (float*)(ws + WS_SSQ), 1.0f};
        GEMM_RUN(pg8::EpiResid, g, S, E);
    }
    SEAM(11);
    if (IN(12)) {
        const AP a = make_ap(); unsigned char* ws = a.ws_();
        pg8::Gemm g{(const bf16*)(ws + WS_XB), (const bf16*)(ws + WS_WGU), NTOK, 2 * FF, DM}; pg8::StaticOrder S; S.init(NTOK, 2 * FF, G, bid);
        pg8::EpiSwiglu E{(bf16*)(ws + WS_ACT), FF, (const float*)(ws + WS_SSQ)};
        GEMM_RUN(pg8::EpiSwiglu, g, S, E);
    }
    SEAM(12);
    if (IN(13)) {
        const AP a = make_ap(); unsigned char* ws = a.ws_();
        pg8::Gemm g{(const bf16*)(ws + WS_ACT), (const bf16*)(ws + WS_WD), NTOK, DM, FF}; pg8::StaticOrder S; S.init(NTOK, DM, G, bid);
        pg8::EpiResid E{a.out_(), a.out_(), nullptr, (float*)(ws + WS_SSQ), 0.5f};
        GEMM_RUN(pg8::EpiResid, g, S, E);
    }
    SEAM(13);
    if (IN(14)) { const AP a = make_ap(); phase_final_norm(a, gw, NGW, lane); }
#undef IN
#undef SEAM
#undef GEMM_RUN
}

extern "C" void kernel_launch(void* const* d_in, const int* in_sizes, int n_in, void* d_out, int out_size, void* d_ws, size_t ws_size, hipStream_t stream) {
    static int grid = 0;
    if (grid == 0) {
        if (n_in != 28 || in_sizes[0] != NTOK * DM || out_size != NTOK * DM || ws_size < WS_END) { fprintf(stderr, "kernel_launch: unexpected shapes / workspace (n_in %d, ws %zu); nothing launched\n", n_in, ws_size); grid = -1; return; }
        int dev = 0, cus = 0;
        if (hipGetDevice(&dev) != hipSuccess || hipDeviceGetAttribute(&cus, hipDeviceAttributeMultiprocessorCount, dev) != hipSuccess) { grid = -1; return; }
        if (hipFuncSetAttribute((const void*)mega, hipFuncAttributeMaxDynamicSharedMemorySize, LDS_BYTES) != hipSuccess) { fprintf(stderr, "kernel_launch: hipFuncSetAttribute failed\n"); grid = -1; return; }
        (void)hipGetLastError();
        grid = cus;
    }
    if (grid < 0) return;
    if (hipMemsetAsync((char*)d_ws + WS_CTL, 0, CTL_ZERO_BYTES, stream) != hipSuccess) return;
    Args a{};
    for (int i = 0; i < 28; ++i) a.in[i] = (const float*)d_in[i];
    a.out = (float*)d_out; a.ws = (unsigned char*)d_ws;
#if MK_ONE_LAUNCH
    a.ph_lo = 0; a.ph_hi = NPH;
    hipLaunchKernelGGL(mega, dim3(grid), dim3(NWAVES * 64), LDS_BYTES, stream, a);
#else
    for (int k = 0; k < NPH; ++k) { a.ph_lo = k; a.ph_hi = k + 1; hipLaunchKernelGGL(mega, dim3(grid), dim3(NWAVES * 64), LDS_BYTES, stream, a); }
#endif
}
```

```cpp
#include <hip/hip_runtime.h>
#include <cstdio>
#include <cstdint>
namespace pg8 {
#define PG8_LAS __attribute__((address_space(3)))
typedef unsigned short bf16_t;
typedef short bf16x8 __attribute__((ext_vector_type(8)));
typedef float f32x4 __attribute__((ext_vector_type(4)));
typedef unsigned u32x4 __attribute__((ext_vector_type(4)));
typedef unsigned u32x2 __attribute__((ext_vector_type(2)));
constexpr int BM = 256, BK = 64, HALF = 128, HTB = HALF * BK * 2  , STAGE_BYTES = 8 * HTB, NXCD = 8, WGM = 8;

__host__ __device__ __forceinline__ int lds_byte(int r, int c) { const int st = (r >> 4) * 2 + (c >> 5), rr = r & 15, cc = c & 31, ob = rr * 64 + cc * 2; return st * 1024 + (ob ^ (((ob >> 9) & 1) << 5)); }
__host__ __device__ __forceinline__ void stage_rc(int b, int& R, int& C) { const int st = b / 1024, sb = b % 1024, swz = sb ^ (((sb >> 9) & 1) << 5); R = (st >> 1) * 16 + swz / 64; C = (st & 1) * 32 + (swz % 64) / 2; }
__host__ __device__ __forceinline__ int perm32(int rho) { const int n = rho >> 4, i = rho & 15; return 8 * (i >> 2) + 4 * n + (i & 3); }

struct Unit { int pm, pn; };
struct Gemm { const bf16_t* A; const bf16_t* Bt; int M, N, K; };

struct StaticOrder {
    int nM, nN, nwg, G, c;
    __host__ __device__ void init(int M, int N, int G_, int c_) { nM = M / BM; nN = N / BM; nwg = nM * nN; G = G_; c = c_; }
    __host__ __device__ bool next(int i, Unit& u) const {
        const long L = (long)i * G + c; if (L >= nwg) return false;
        int wgid = (int)L; { const int q = nwg / NXCD, r = nwg % NXCD, xcd = wgid % NXCD, off = wgid / NXCD; wgid = (xcd < r ? xcd * (q + 1) : r * (q + 1) + (xcd - r) * q) + off; }
        const int nig = WGM * nN, gid = wgid / nig, fm = gid * WGM, gsz = (nM - fm) < WGM ? (nM - fm) : WGM;
        u.pm = fm + ((wgid % nig) % gsz); u.pn = (wgid % nig) / gsz; return true;
    }
    __device__ __forceinline__ void a_ready(const Unit&) const {}
    __device__ __forceinline__ void done(const Unit&) const {}
};

__device__ __forceinline__ unsigned cvt_pk_bf16(float lo, float hi) { unsigned r; asm volatile("v_cvt_pk_bf16_f32 %0, %1, %2" : "=v"(r) : "v"(lo), "v"(hi)); return r; }

__device__ __forceinline__ float row_rstd(const float* ssq, int row, int fq) {
    const f32x4* p = (const f32x4*)(ssq + (size_t)row * 32 + 8 * fq);
    const f32x4 a = p[0], b = p[1];
    float s = ((a[0] + a[1]) + (a[2] + a[3])) + ((b[0] + b[1]) + (b[2] + b[3]));
    s += __shfl_xor(s, 16); s += __shfl_xor(s, 32);
    return __builtin_amdgcn_rsqf(s * (1.0f / 2048.0f) + 1e-6f);
}
__device__ __forceinline__ float silu_f(float x) { return x * __builtin_amdgcn_rcpf(1.0f + __expf(-x)); }

struct EpiScaleBf16 {
    static constexpr bool PERM = true, AFTER_DRAIN = false;
    bf16_t* O; int ldc; const float* ssq;
    __device__ __forceinline__ void operator()(const f32x4 (&acc)[2][2][4][2], const Unit& u, int wr, int wc, int fr, int fq) const {
        const int row0 = u.pm * BM + wr * 64 + fr, col0 = u.pn * BM + wc * 32 + 8 * fq;
#pragma unroll
        for (int ai = 0; ai < 2; ++ai)
#pragma unroll
            for (int m = 0; m < 4; ++m) { const int row = row0 + ai * HALF + m * 16; const float rs = ssq ? row_rstd(ssq, row, fq) : 1.0f;
                bf16_t* rowp = O + (size_t)row * ldc + col0;
#pragma unroll
                for (int bj = 0; bj < 2; ++bj) { const f32x4 v0 = acc[ai][bj][m][0] * rs, v1 = acc[ai][bj][m][1] * rs;
                    u32x4 w; w.x = cvt_pk_bf16(v0[0], v0[1]); w.y = cvt_pk_bf16(v0[2], v0[3]); w.z = cvt_pk_bf16(v1[0], v1[1]); w.w = cvt_pk_bf16(v1[2], v1[3]);
                    *(u32x4*)(rowp + bj * HALF) = w; } }
    }
};
struct EpiSiluBf16 {
    static constexpr bool PERM = true, AFTER_DRAIN = false;
    bf16_t* O; int ldc;
    __device__ __forceinline__ void operator()(const f32x4 (&acc)[2][2][4][2], const Unit& u, int wr, int wc, int fr, int fq) const {
        const int row0 = u.pm * BM + wr * 64 + fr, col0 = u.pn * BM + wc * 32 + 8 * fq;
#pragma unroll
        for (int ai = 0; ai < 2; ++ai)
#pragma unroll
            for (int m = 0; m < 4; ++m) { bf16_t* rowp = O + (size_t)(row0 + ai * HALF + m * 16) * ldc + col0;
#pragma unroll
                for (int bj = 0; bj < 2; ++bj) { const f32x4 v0 = acc[ai][bj][m][0], v1 = acc[ai][bj][m][1];
                    u32x4 w; w.x = cvt_pk_bf16(silu_f(v0[0]), silu_f(v0[1])); w.y = cvt_pk_bf16(silu_f(v0[2]), silu_f(v0[3])); w.z = cvt_pk_bf16(silu_f(v1[0]), silu_f(v1[1])); w.w = cvt_pk_bf16(silu_f(v1[2]), silu_f(v1[3]));
                    *(u32x4*)(rowp + bj * HALF) = w; } }
    }
};
struct EpiSwiglu {
    static constexpr bool PERM = true, AFTER_DRAIN = false;
    bf16_t* O; int ldc; const float* ssq;
    __device__ __forceinline__ void operator()(const f32x4 (&acc)[2][2][4][2], const Unit& u, int wr, int wc, int fr, int fq) const {
        const int row0 = u.pm * BM + wr * 64 + fr, col0 = u.pn * HALF + wc * 32 + 8 * fq;
#pragma unroll
        for (int ai = 0; ai < 2; ++ai)
#pragma unroll
            for (int m = 0; m < 4; ++m) { const int row = row0 + ai * HALF + m * 16; const float rs = row_rstd(ssq, row, fq);
                const f32x4 g0 = acc[ai][0][m][0] * rs, g1 = acc[ai][0][m][1] * rs, u0 = acc[ai][1][m][0] * rs, u1 = acc[ai][1][m][1] * rs;
                f32x4 a0, a1;
#pragma unroll
                for (int i = 0; i < 4; ++i) { a0[i] = silu_f(g0[i]) * u0[i]; a1[i] = silu_f(g1[i]) * u1[i]; }
                u32x4 w; w.x = cvt_pk_bf16(a0[0], a0[1]); w.y = cvt_pk_bf16(a0[2], a0[3]); w.z = cvt_pk_bf16(a1[0], a1[1]); w.w = cvt_pk_bf16(a1[2], a1[3]);
                *(u32x4*)(O + (size_t)row * ldc + col0) = w; }
    }
};
struct EpiResid {
    static constexpr bool PERM = false, AFTER_DRAIN = false;
    const float* base; float* out; bf16_t* xb; float* ssq_out; float scale;
    __device__ __forceinline__ void operator()(const f32x4 (&acc)[2][2][4][2], const Unit& u, int wr, int wc, int fr, int fq) const {
        const int row0 = u.pm * BM + wr * 64 + fr, col0 = u.pn * BM + wc * 32 + 4 * fq;
#pragma unroll
        for (int ai = 0; ai < 2; ++ai)
#pragma unroll
            for (int m = 0; m < 4; ++m) { const int row = row0 + ai * HALF + m * 16; const size_t off = (size_t)row * 2048 + col0; float ss = 0.f;
#pragma unroll
                for (int bj = 0; bj < 2; ++bj)
#pragma unroll
                    for (int n = 0; n < 2; ++n) { const size_t c = off + bj * HALF + n * 16; const f32x4 b = *(const f32x4*)(base + c); const f32x4 v = b + acc[ai][bj][m][n] * scale;
                        *(f32x4*)(out + c) = v; ss += (v[0] * v[0] + v[1] * v[1]) + (v[2] * v[2] + v[3] * v[3]);
                        if (xb) { u32x2 w; w.x = cvt_pk_bf16(v[0], v[1]); w.y = cvt_pk_bf16(v[2], v[3]); *(u32x2*)(xb + c) = w; } }
                ss += __shfl_xor(ss, 16); ss += __shfl_xor(ss, 32);
                if (fq == 0) ssq_out[(size_t)row * 32 + u.pn * 4 + wc] = ss; }
    }
};

template <class Epi, class Sched, bool ALIGN_EPI = false, bool SP2 = false>
__device__ __forceinline__ void gemm_phase(PG8_LAS unsigned char* lds, const Gemm g, const Sched& S, const Epi& E) {
    int tid_ = threadIdx.x; asm volatile("" : "+v"(tid_));
    const int tid = tid_, wid = __builtin_amdgcn_readfirstlane(tid >> 6), lane = tid & 63, wr = wid >> 2, wc = wid & 3, fr = lane & 15, fq = lane >> 4;
    const int K = g.K, nt = K / BK;
    unsigned voffA[2], voffB[2];
#pragma unroll
    for (int i = 0; i < 2; ++i) { int R, C; stage_rc(tid * 16 + i * 8192, R, C); const int Rb = Epi::PERM ? ((R & ~31) + perm32(R & 31)) : R;
        voffA[i] = (unsigned)(R * K + C) * 2u; voffB[i] = (unsigned)(Rb * K + C) * 2u; }
    const size_t kstep = (size_t)(BK * 2);
    const size_t hstep = (size_t)HALF * K * 2;
    const size_t tstep = 2 * hstep;
    const unsigned ldsw = (unsigned)wid * 1024u;
    const int aoff = lds_byte(wr * 64 + fr, fq * 8), boff = lds_byte(wc * 32 + fr, fq * 8);
#define PG8_SA(b, h) (((b) * 2 + (h)) * HTB)
#define PG8_SB(b, h) ((4 + (b) * 2 + (h)) * HTB)
#define PG8_STAGE(bufoff, gbase, voff) do { _Pragma("unroll") for (int _i = 0; _i < 2; ++_i) \
        __builtin_amdgcn_global_load_lds((const unsigned*)((const char*)(gbase) + (voff)[_i]), (PG8_LAS unsigned*)(lds + (bufoff) + ldsw + _i * 8192), 16, 0, 0); } while (0)
#define PG8_LDA(dst, b, h) do { _Pragma("unroll") for (int m = 0; m < 4; ++m) _Pragma("unroll") for (int k = 0; k < 2; ++k) dst[m][k] = *(const PG8_LAS bf16x8*)(lds + PG8_SA(b, h) + aoff + m * 2048 + k * 1024); } while (0)
#define PG8_LDB(dst, b, h) do { _Pragma("unroll") for (int n = 0; n < 2; ++n) _Pragma("unroll") for (int k = 0; k < 2; ++k) dst[n][k] = *(const PG8_LAS bf16x8*)(lds + PG8_SB(b, h) + boff + n * 2048 + k * 1024); } while (0)
#define PG8_MMA(ai, bj, At, Bt) do { __builtin_amdgcn_s_setprio(1); _Pragma("unroll") for (int m = 0; m < 4; ++m) _Pragma("unroll") for (int n = 0; n < 2; ++n) _Pragma("unroll") for (int k = 0; k < 2; ++k) \
        acc[ai][bj][m][n] = __builtin_amdgcn_mfma_f32_16x16x32_bf16(Bt[n][k], At[m][k], acc[ai][bj][m][n], 0, 0, 0); __builtin_amdgcn_s_setprio(0); } while (0)
#define PG8_WAIT_V(n) asm volatile("s_waitcnt vmcnt(" #n ")" ::: "memory")
#define PG8_WAIT_L(n) asm volatile("s_waitcnt lgkmcnt(" #n ")" ::: "memory")
#define PG8_BAR __builtin_amdgcn_s_barrier()
#define PG8_SCHED __builtin_amdgcn_sched_barrier(0)
    Unit cur, nxt; int ui = 0;
    if (!S.next(0, cur)) return;
    f32x4 acc[2][2][4][2];
#pragma unroll
    for (int a = 0; a < 2; ++a)
#pragma unroll
        for (int b = 0; b < 2; ++b)
#pragma unroll
            for (int m = 0; m < 4; ++m)
#pragma unroll
                for (int n = 0; n < 2; ++n) acc[a][b][m][n] = (f32x4){0.f, 0.f, 0.f, 0.f};
    bf16x8 At[4][2], B0[2][2], B1[2][2];
    const char* cA = (const char*)g.A + (size_t)cur.pm * tstep; const char* cB = (const char*)g.Bt + (size_t)cur.pn * tstep;
    S.a_ready(cur);
    if constexpr (SP2) {
        PG8_STAGE(PG8_SB(0, 0), cB, voffB); PG8_STAGE(PG8_SB(0, 1), cB + hstep, voffB); PG8_STAGE(PG8_SA(0, 0), cA, voffA); PG8_STAGE(PG8_SA(0, 1), cA + hstep, voffA);
        if (wr == 1) PG8_BAR;
        PG8_WAIT_V(2); PG8_BAR;
        PG8_STAGE(PG8_SB(1, 0), cB + kstep, voffB); PG8_STAGE(PG8_SA(1, 0), cA + kstep, voffA); PG8_STAGE(PG8_SB(1, 1), cB + hstep + kstep, voffB);
        PG8_WAIT_V(6); PG8_BAR;
    } else {
        PG8_STAGE(PG8_SB(0, 0), cB, voffB); PG8_STAGE(PG8_SA(0, 0), cA, voffA); PG8_STAGE(PG8_SB(0, 1), cB + hstep, voffB); PG8_STAGE(PG8_SA(0, 1), cA + hstep, voffA);
        if (wr == 1) PG8_BAR;
        PG8_WAIT_V(4); PG8_BAR;
        PG8_STAGE(PG8_SB(1, 0), cB + kstep, voffB); PG8_STAGE(PG8_SA(1, 0), cA + kstep, voffA); PG8_STAGE(PG8_SB(1, 1), cB + hstep + kstep, voffB);
        PG8_WAIT_V(6); PG8_BAR;
    }
    for (;;) {
        const bool has_next = S.next(ui + 1, nxt);
        const char* nA = has_next ? (const char*)g.A + (size_t)nxt.pm * tstep : cA; const char* nB = has_next ? (const char*)g.Bt + (size_t)nxt.pn * tstep : cB;
        for (int t = 0; t < nt; t += 2) {
            const bool last = (t == nt - 2);
            const char* a1 = cA + (size_t)(t + 1) * kstep;
            const char* a2 = last ? nA : cA + (size_t)(t + 2) * kstep; const char* b2 = last ? nB : cB + (size_t)(t + 2) * kstep;
            const char* a3 = a2 + kstep; const char* b3 = b2 + kstep;
            if (last && has_next) S.a_ready(nxt);
            if constexpr (SP2) {
            PG8_LDB(B0, 0, 0); PG8_LDB(B1, 0, 1); PG8_SCHED; PG8_LDA(At, 0, 0); PG8_STAGE(PG8_SA(1, 1), a1 + hstep, voffA);
            PG8_WAIT_V(8); PG8_WAIT_L(0); PG8_BAR; PG8_MMA(0, 0, At, B0); PG8_MMA(0, 1, At, B1); PG8_BAR; PG8_SCHED;
            PG8_LDA(At, 0, 1); PG8_STAGE(PG8_SB(0, 0), b2, voffB); PG8_STAGE(PG8_SB(0, 1), b2 + hstep, voffB); PG8_STAGE(PG8_SA(0, 0), a2, voffA);
            PG8_WAIT_V(8); PG8_WAIT_L(0); PG8_BAR; PG8_MMA(1, 0, At, B0); PG8_MMA(1, 1, At, B1); PG8_BAR; PG8_SCHED;
            PG8_LDB(B0, 1, 0); PG8_LDB(B1, 1, 1); PG8_SCHED; PG8_LDA(At, 1, 0); PG8_STAGE(PG8_SA(0, 1), a2 + hstep, voffA);
            PG8_WAIT_V(8); PG8_WAIT_L(0); PG8_BAR; PG8_MMA(0, 0, At, B0); PG8_MMA(0, 1, At, B1); PG8_BAR; PG8_SCHED;
            PG8_LDA(At, 1, 1); PG8_STAGE(PG8_SB(1, 0), b3, voffB); PG8_STAGE(PG8_SB(1, 1), b3 + hstep, voffB); PG8_STAGE(PG8_SA(1, 0), a3, voffA);
            PG8_WAIT_V(8); PG8_WAIT_L(0); PG8_BAR; PG8_MMA(1, 0, At, B0); PG8_MMA(1, 1, At, B1); PG8_BAR; PG8_SCHED;
            } else {
            PG8_LDB(B0, 0, 0); PG8_SCHED; PG8_LDA(At, 0, 0); PG8_STAGE(PG8_SA(1, 1), a1 + hstep, voffA);
            PG8_WAIT_L(8); PG8_BAR; PG8_WAIT_L(0); PG8_MMA(0, 0, At, B0); PG8_BAR; PG8_SCHED;
            PG8_LDB(B1, 0, 1); PG8_STAGE(PG8_SB(0, 0), b2, voffB);
            PG8_BAR; PG8_WAIT_L(0); PG8_MMA(0, 1, At, B1); PG8_BAR;
            PG8_LDA(At, 0, 1); PG8_STAGE(PG8_SA(0, 0), a2, voffA);
            PG8_BAR; PG8_WAIT_L(0); PG8_MMA(1, 0, At, B0); PG8_BAR; PG8_SCHED;
            PG8_STAGE(PG8_SB(0, 1), b2 + hstep, voffB);
            PG8_WAIT_V(6); PG8_BAR; PG8_MMA(1, 1, At, B1); PG8_BAR;
            PG8_LDB(B0, 1, 0); PG8_SCHED; PG8_LDA(At, 1, 0); PG8_STAGE(PG8_SA(0, 1), a2 + hstep, voffA);
            PG8_WAIT_L(8); PG8_BAR; PG8_WAIT_L(0); PG8_MMA(0, 0, At, B0); PG8_BAR; PG8_SCHED;
            PG8_LDB(B1, 1, 1); PG8_STAGE(PG8_SB(1, 0), b3, voffB);
            PG8_BAR; PG8_WAIT_L(0); PG8_MMA(0, 1, At, B1); PG8_BAR;
            PG8_LDA(At, 1, 1); PG8_STAGE(PG8_SA(1, 0), a3, voffA);
            PG8_BAR; PG8_WAIT_L(0); PG8_MMA(1, 0, At, B0); PG8_BAR; PG8_SCHED;
            PG8_STAGE(PG8_SB(1, 1), b3 + hstep, voffB);
            PG8_WAIT_V(6); PG8_BAR; PG8_MMA(1, 1, At, B1); PG8_BAR;
            }
        }
        if constexpr (ALIGN_EPI) { if (wr == 0) PG8_BAR; }
        if constexpr (!Epi::AFTER_DRAIN) { E(acc, cur, wr, wc, fr, fq); S.done(cur); }
        if (!has_next) break;
#pragma unroll
        for (int a = 0; a < 2; ++a)
#pragma unroll
            for (int b = 0; b < 2; ++b)
#pragma unroll
                for (int m = 0; m < 4; ++m)
#pragma unroll
                    for (int n = 0; n < 2; ++n) acc[a][b][m][n] = (f32x4){0.f, 0.f, 0.f, 0.f};
        cur = nxt; cA = nA; cB = nB; ++ui;
        if constexpr (ALIGN_EPI) { if (wr == 1) PG8_BAR; }
    }
    PG8_WAIT_V(0);
    if constexpr (!ALIGN_EPI) { if (wr == 0) PG8_BAR; }
    PG8_BAR;
    if constexpr (Epi::AFTER_DRAIN) { E.fused(acc, cur, wr, wc, fr, fq, lds, wid, lane); S.done(cur); }
#undef PG8_SA
#undef PG8_SB
#undef PG8_STAGE
#undef PG8_LDA
#undef PG8_LDB
#undef PG8_MMA
#undef PG8_WAIT_V
#undef PG8_WAIT_L
#undef PG8_BAR
#undef PG8_SCHED
}
}
#define GAS __attribute__((address_space(1)))
#define LAS __attribute__((address_space(3)))
typedef unsigned short bf16;
typedef unsigned v4u __attribute__((ext_vector_type(4)));
typedef float f32x4 __attribute__((ext_vector_type(4)));
typedef short bf16x8 __attribute__((ext_vector_type(8)));
typedef GAS unsigned gu32;
typedef GAS unsigned long long gu64;
#define RLX_AGENT __ATOMIC_RELAXED, __HIP_MEMORY_SCOPE_AGENT
#define LDS_WAIT() asm volatile("s_waitcnt lgkmcnt(0)" ::: "memory")
#define VM_WAIT() asm volatile("s_waitcnt vmcnt(0)" ::: "memory")
__device__ __forceinline__ unsigned long long rt() { return __builtin_amdgcn_s_memrealtime(); }
__device__ __forceinline__ unsigned f2bf(float f) { unsigned u = __builtin_bit_cast(unsigned, f); return (u + 0x7fffu + ((u >> 16) & 1u)) >> 16; }
__device__ __forceinline__ unsigned pk2(float lo, float hi) { return f2bf(lo) | (f2bf(hi) << 16); }

#define XB_TMO      128
#define XB_XCNT(j)  (256  + 64 * (j))
#define XB_XSUB(j)  (1280 + 64 * (j))
#define XB_XGEN(j)  (2304 + 64 * (j))
#define XB_TOP      3328
#define XB_TOPGEN   3392
#define XCD_BAR_WORDS 3456
#define XB_SPIN_CAP (1u << 18)

__device__ __forceinline__ unsigned xb_ld(unsigned* p)              { return __hip_atomic_load(p, __ATOMIC_RELAXED, __HIP_MEMORY_SCOPE_AGENT); }
__device__ __forceinline__ unsigned xb_add(unsigned* p, unsigned v) { return __hip_atomic_fetch_add(p, v, __ATOMIC_RELAXED, __HIP_MEMORY_SCOPE_AGENT); }
__device__ __forceinline__ unsigned xb_xcc_id() { return (unsigned)__builtin_amdgcn_s_getreg((3 << 11) | 20) & 0xFu; }
#define XB_SPIN(cond, bar) do { unsigned _sp = 0; while (cond) { __builtin_amdgcn_s_sleep(1); \
    if ((++_sp & 255u) == 0u) { if (xb_ld(&(bar)[XB_TMO])) break; if (_sp > XB_SPIN_CAP) { atomicAdd(&(bar)[XB_TMO], 1u); break; } } } } while (0)

struct XcdBarrier {
    unsigned* bar; unsigned x;
    volatile LAS unsigned* st;
};

__device__ __forceinline__ XcdBarrier xcd_barrier_post(unsigned* bar, volatile LAS unsigned* st) {
    XcdBarrier b; b.bar = bar; b.x = xb_xcc_id(); b.st = st;
    if (threadIdx.x == 0) (void)xb_add(&bar[XB_XCNT(b.x)], 1u);
    return b;
}
__device__ __forceinline__ void xcd_barrier_complete(unsigned* bar, unsigned x, unsigned& nloc, unsigned& nx) {
    const unsigned G = gridDim.x * gridDim.y * gridDim.z;
    unsigned sum, cnt, mine, sp = 0u;
    for (;;) {
        sum = 0u; cnt = 0u; mine = 0u;
#pragma unroll
        for (unsigned j = 0; j < 16; ++j) { const unsigned c = xb_ld(&bar[XB_XCNT(j)]); sum += c; cnt += (c > 0u) ? 1u : 0u; mine = (j == x) ? c : mine; }
        if (sum == G) break;
        __builtin_amdgcn_s_sleep(1);
        if ((++sp & 255u) == 0u) { if (xb_ld(&bar[XB_TMO])) break; if (sp > XB_SPIN_CAP) { atomicAdd(&bar[XB_TMO], 1u); break; } }
    }
    nloc = mine > 0u ? mine : 1u; nx = cnt > 0u ? cnt : 1u;
}

__device__ __forceinline__ void xcd_barrier(const XcdBarrier& b) {
    asm volatile("s_waitcnt vmcnt(0)" ::: "memory");
    __syncthreads();
    if (threadIdx.x == 0) {
        unsigned* bar = b.bar;
        __builtin_amdgcn_s_waitcnt(0);
        unsigned nloc = b.st[0], nx = b.st[1];
        if (nloc == 0u) { xcd_barrier_complete(bar, b.x, nloc, nx); b.st[0] = nloc; b.st[1] = nx; }
        const unsigned old = xb_add(&bar[XB_XSUB(b.x)], 1u);
        const unsigned gen = old / nloc;
        if (old + 1u == (gen + 1u) * nloc) {
            __builtin_amdgcn_fence(__ATOMIC_RELEASE, "agent");
            asm volatile("s_waitcnt vmcnt(0)" ::: "memory");
            const unsigned og = xb_add(&bar[XB_TOP], 1u);
            const unsigned tg = og / nx;
            if (og + 1u == (tg + 1u) * nx) xb_add(&bar[XB_TOPGEN], 1u);
            else XB_SPIN(xb_ld(&bar[XB_TOPGEN]) == tg, bar);
            __builtin_amdgcn_fence(__ATOMIC_ACQUIRE, "agent");
            xb_add(&bar[XB_XGEN(b.x)], 1u);
            asm volatile("s_waitcnt vmcnt(0)" ::: "memory");
        } else {
            XB_SPIN(xb_ld(&bar[XB_XGEN(b.x)]) == gen, bar);
            __builtin_amdgcn_fence(__ATOMIC_ACQUIRE, "agent");
            asm volatile("s_waitcnt vmcnt(0)" ::: "memory");
        }
    }
    __syncthreads();
}

constexpr int NTOK = 8192, SEQ = 4096, DM = 2048, FF = 5632, DIN = 5936, DINP = 6144;
constexpr int C_HQ = 0, C_HF = 1024, C_HI = 2048, C_HG = 3072, C_NQ = 4096, C_KC = 5120, C_VC = 5248, C_KS = 5376, C_VS = 5504, C_KW = 5632, C_VW = 5760, C_GATE = 5888;
constexpr int NPH = 15;
#ifndef MK_ONE_LAUNCH
#define MK_ONE_LAUNCH 1
#endif
constexpr int NWAVES = 8;
constexpr size_t MiB = 1u << 20;
constexpr size_t WS_CTL = 0, CTL_ZERO_BYTES = 1 * MiB;
constexpr size_t WS_SSQ = 1 * MiB, WS_COS = 2 * MiB, WS_SIN = 3 * MiB, WS_LB = 4 * MiB, WS_KC = 4 * MiB + 65536, WS_VC = WS_KC + 262144, WS_HD = 5 * MiB;
constexpr size_t WS_WGU = 8 * MiB, WS_WD = 52 * MiB, WS_WIN = 74 * MiB, WS_WOUT = 98 * MiB, WS_WQ = 106 * MiB, WS_WKV = 108 * MiB, WS_WO = 112 * MiB;
constexpr size_t WS_XB = 114 * MiB, WS_ACT = 146 * MiB, WS_QR = 210 * MiB, WS_CA = 226 * MiB, WS_PROJ = 234 * MiB, WS_OMIX = 330 * MiB;
constexpr size_t WS_UT = 114 * MiB  , WS_ST = 178 * MiB  ;
constexpr size_t WS_KCR = 362 * MiB, WS_KSR = 364 * MiB, WS_KWR = 366 * MiB, WS_GATE = 368 * MiB, WS_QX = 370 * MiB, WS_OX = 378 * MiB, WS_KVX = 386 * MiB, WS_MEMN = 387 * MiB, WS_W1T = 389 * MiB, WS_HID = 391 * MiB, WS_END = 392 * MiB;
constexpr int CW_BAR = 4096;
constexpr int RING_OFF = 0, RING_BYTES = 131072;
constexpr int LDSCTL_OFF = RING_BYTES, MISC_OFF = LDSCTL_OFF + 320;
constexpr int LDS_BYTES = 147456;

#define DI __device__ __forceinline__
DI float bf2f(unsigned short h) { return __uint_as_float((unsigned)h << 16); }
DI float wave_sum(float v) {
#pragma unroll
    for (int o = 1; o < 64; o <<= 1) v += __shfl_xor(v, o);
    return v;
}
DI float wave_max(float v) {
#pragma unroll
    for (int o = 1; o < 64; o <<= 1) v = fmaxf(v, __shfl_xor(v, o));
    return v;
}
using pg8::silu_f;
DI float sigmoid_f(float x) { return 1.0f / (1.0f + __expf(-x)); }

struct Args { const float* in[28]; float* out; unsigned char* ws; int ph_lo, ph_hi; };
typedef const __attribute__((address_space(4))) unsigned char* kaptr_t;
struct AP {
    kaptr_t ka;
    __device__ __forceinline__ const float* in_(int i) const { return *(const float* const __attribute__((address_space(4)))*)(ka + 8 * i); }
    __device__ __forceinline__ float* out_() const { return *(float* const __attribute__((address_space(4)))*)(ka + 8 * 28); }
    __device__ __forceinline__ unsigned char* ws_() const { return *(unsigned char* const __attribute__((address_space(4)))*)(ka + 8 * 29); }
};
__device__ __forceinline__ AP make_ap() { kaptr_t k = (kaptr_t)__builtin_amdgcn_kernarg_segment_ptr(); asm volatile("" : "+s"(k)); AP a; a.ka = k; return a; }

__constant__ float ROPE_INV[32] = {1.000000000e+00f, 7.498942614e-01f, 5.623413324e-01f, 4.216965139e-01f, 3.162277639e-01f, 2.371373773e-01f, 1.778279394e-01f, 1.333521307e-01f, 1.000000015e-01f, 7.498941571e-02f, 5.623413250e-02f, 4.216965288e-02f, 3.162277490e-02f, 2.371373773e-02f, 1.778279431e-02f, 1.333521493e-02f, 9.999999776e-03f, 7.498941850e-03f, 5.623413250e-03f, 4.216964822e-03f, 3.162277630e-03f, 2.371373586e-03f, 1.778279431e-03f, 1.333521446e-03f, 1.000000047e-03f, 7.498942432e-04f, 5.623413017e-04f, 4.216965172e-04f, 3.162277571e-04f, 2.371373703e-04f, 1.778279402e-04f, 1.333521504e-04f};

DI void sincos_acc(float angf, float& c, float& s) {
    const double x = (double)angf;
    const double n = __builtin_rint(x * 0.63661977236758134308);
    double r = __builtin_fma(-n, 1.57079632679489655800, x); r = __builtin_fma(-n, 6.12323399573676603587e-17, r);
    const int q = ((int)n) & 3;
    const double r2 = r * r;
    const double sp = r * (1.0 + r2 * (-1.0 / 6.0 + r2 * (1.0 / 120.0 + r2 * (-1.0 / 5040.0 + r2 * (1.0 / 362880.0 + r2 * (-1.0 / 39916800.0 + r2 * (1.0 / 6227020800.0 + r2 * (-1.0 / 1307674368000.0))))))));
    const double cp = 1.0 + r2 * (-0.5 + r2 * (1.0 / 24.0 + r2 * (-1.0 / 720.0 + r2 * (1.0 / 40320.0 + r2 * (-1.0 / 3628800.0 + r2 * (1.0 / 479001600.0 + r2 * (-1.0 / 87178291200.0 + r2 * (1.0 / 20922789888000.0))))))));
    const double sv = (q == 0) ? sp : (q == 1) ? cp : (q == 2) ? -sp : -cp;
    const double cv = (q == 0) ? cp : (q == 1) ? -sp : (q == 2) ? -cp : sp;
    c = (float)cv; s = (float)sv;
}

DI void tr_item(const float* W, int K, int N, bf16* WT, int dst_row0, const float* ks, LAS float* scr, int k0, int n0, int lane) {
    const int n = n0 + (lane & 31); const bool ok = n < N;
#pragma unroll 8
    for (int i = 0; i < 32; ++i) { const int kk = 2 * i + (lane >> 5); float v = ok ? W[(size_t)(k0 + kk) * N + n] : 0.f; if (ks) v *= ks[k0 + kk]; scr[kk * 33 + (lane & 31)] = v; }
    LDS_WAIT(); asm volatile("" ::: "memory");
    const int c = lane & 7;
#pragma unroll
    for (int j = 0; j < 4; ++j) { const int nn = (lane >> 3) + 8 * j; const LAS float* s = scr + (8 * c) * 33 + nn;
        v4u o; o.x = pk2(s[0 * 33], s[1 * 33]); o.y = pk2(s[2 * 33], s[3 * 33]); o.z = pk2(s[4 * 33], s[5 * 33]); o.w = pk2(s[6 * 33], s[7 * 33]);
        *(GAS v4u*)(WT + (size_t)(dst_row0 + nn) * K + k0 + 8 * c) = o; }
    LDS_WAIT(); asm volatile("" ::: "memory");
}
DI bool tr_job(int& r, const float* W, int K, int N, bf16* WT, int mode, int row_off, const float* ks, LAS float* scr, int lane) {
    const int nblk = (N + 31) / 32, nitems = (K / 64) * nblk;
    if (r >= nitems) { r -= nitems; return false; }
    const int kb = r / nblk, nb = r % nblk, n0 = 32 * nb;
    const int dst = (mode == 0) ? row_off + n0 : ((n0 >> 7) * 256 + (n0 & 127) + (mode == 2 ? 128 : 0));
    tr_item(W, K, N, WT, dst, ks, scr, 64 * kb, n0, lane);
    return true;
}
DI void row_to_bf16(const float* xrow, bf16* orow, float* ssq_row, const float* w, int lane) {
    const GAS f32x4* xr = (const GAS f32x4*)xrow + lane;
    f32x4 v[8]; float s = 0.f;
#pragma unroll
    for (int j = 0; j < 8; ++j) { v[j] = xr[64 * j]; s += (v[j].x * v[j].x + v[j].y * v[j].y) + (v[j].z * v[j].z + v[j].w * v[j].w); }
    s = wave_sum(s);
    float rs = 1.f;
    if (w) rs = __builtin_amdgcn_rsqf(s * (1.0f / 2048.0f) + 1e-6f);
    GAS unsigned long long* o8 = (GAS unsigned long long*)orow + lane;
#pragma unroll
    for (int j = 0; j < 8; ++j) { f32x4 t = v[j] * rs; if (w) { const f32x4 wv = ((const GAS f32x4*)w)[lane + 64 * j]; t = t * wv; }
        o8[64 * j] = (unsigned long long)pk2(t.x, t.y) | ((unsigned long long)pk2(t.z, t.w) << 32); }
    if (ssq_row && lane < 32) ssq_row[lane] = (lane == 0) ? s : 0.f;
}

DI void phase_prologue(const AP a, LAS unsigned char* lds, int gw, int NGW, int wave, int lane) {
    unsigned char* ws = a.ws_();
    LAS float* scr = (LAS float*)(lds + RING_OFF + wave * 16384);
    constexpr int I_GU = 32 * 176, I_D = 88 * 64, I_IN = 32 * 186, I_OUT = 32 * 64, I_Q = 32 * 16, I_O = 8 * 64;
    constexpr int I_C = 32 * 8;
    constexpr int NITEMS = 2 * I_GU + I_D + I_IN + I_OUT + 3 * I_Q + I_O + 2 * I_C;
    for (int it = gw; it < NITEMS; it += NGW) {
        int r = it;
        if (tr_job(r, a.in_(4), DM, FF, (bf16*)(ws + WS_WGU), 1, 0, a.in_(3), scr, lane)) continue;
        if (tr_job(r, a.in_(5), DM, FF, (bf16*)(ws + WS_WGU), 2, 0, a.in_(3), scr, lane)) continue;
        if (tr_job(r, a.in_(6), FF, DM, (bf16*)(ws + WS_WD), 0, 0, nullptr, scr, lane)) continue;
        if (tr_job(r, a.in_(8), DM, DIN, (bf16*)(ws + WS_WIN), 0, 0, a.in_(7), scr, lane)) continue;
        if (tr_job(r, a.in_(16), DM, DM, (bf16*)(ws + WS_WOUT), 0, 0, nullptr, scr, lane)) continue;
        if (tr_job(r, a.in_(19), DM, 512, (bf16*)(ws + WS_WQ), 0, 0, a.in_(17), scr, lane)) continue;
        if (tr_job(r, a.in_(20), DM, 512, (bf16*)(ws + WS_WKV), 0, 0, nullptr, scr, lane)) continue;
        if (tr_job(r, a.in_(21), DM, 512, (bf16*)(ws + WS_WKV), 0, 512, nullptr, scr, lane)) continue;
        if (tr_job(r, a.in_(22), 512, DM, (bf16*)(ws + WS_WO), 0, 0, nullptr, scr, lane)) continue;
        if (tr_job(r, a.in_(12), 2048, 256, (bf16*)(ws + WS_W1T), 0, 0, nullptr, scr, lane)) continue;
        tr_job(r, a.in_(14), 2048, 256, (bf16*)(ws + WS_W1T), 0, 256, nullptr, scr, lane);
    }
    for (int m = gw; m < NTOK; m += NGW) row_to_bf16(a.in_(0) + (size_t)m * DM, (bf16*)(ws + WS_XB) + (size_t)m * DM, (float*)(ws + WS_SSQ) + (size_t)m * 32, nullptr, lane);
    for (int m = gw; m < 512; m += NGW) row_to_bf16(a.in_(1) + (size_t)m * DM, (bf16*)(ws + WS_MEMN) + (size_t)m * DM, nullptr, a.in_(18), lane);
    {
        const int* pos = (const int*)a.in_(2); float* ct = (float*)(ws + WS_COS); float* st = (float*)(ws + WS_SIN);
        for (int it = gw; it < NTOK / 2; it += NGW) { const int tok = 2 * it + (lane >> 5), i = lane & 31;
            const float ang = (float)pos[tok] * ROPE_INV[i]; float c, s; sincos_acc(ang, c, s); ct[tok * 32 + i] = c; st[tok * 32 + i] = s; }
    }
    {
        const float* lg = a.in_(9); float* lb = (float*)(ws + WS_LB);
        for (int it = gw; it < 16; it += NGW) { const int i = it * 64 + lane; lb[i] = 1.0f / (1.0f + expf(lg[1024 + i] - lg[i])); }
    }
}
DI void phase_ffn2_weights(const AP a, LAS unsigned char* lds, int gw, int NGW, int wave, int lane) {
    unsigned char* ws = a.ws_();
    LAS float* scr = (LAS float*)(lds + RING_OFF + wave * 16384 + 4096);
    constexpr int I_GU = 32 * 176, I_D = 88 * 64, NITEMS = 2 * I_GU + I_D;
    for (int it = gw; it < NITEMS; it += NGW) {
        int r = it;
        if (tr_job(r, a.in_(24), DM, FF, (bf16*)(ws + WS_WGU), 1, 0, a.in_(23), scr, lane)) continue;
        if (tr_job(r, a.in_(25), DM, FF, (bf16*)(ws + WS_WGU), 2, 0, a.in_(23), scr, lane)) continue;
        tr_job(r, a.in_(26), FF, DM, (bf16*)(ws + WS_WD), 0, 0, nullptr, scr, lane);
    }
}

DI void phase_postproj(const AP a, int gw, int NGW, int lane) {
    unsigned char* ws = a.ws_();
    const bf16* proj = (const bf16*)(ws + WS_PROJ); const float* ct = (const float*)(ws + WS_COS); const float* st = (const float*)(ws + WS_SIN);
    const float* pe = a.in_(11);
    bf16* qr = (bf16*)(ws + WS_QR); bf16* ksr = (bf16*)(ws + WS_KSR); bf16* kwr = (bf16*)(ws + WS_KWR); float* gate = (float*)(ws + WS_GATE);
    for (int tok = gw; tok < NTOK; tok += NGW) {
        const bf16* pr = proj + (size_t)tok * DINP;
#pragma unroll
        for (int j = 0; j < 8; ++j) { const int p = lane + 64 * j, head = p >> 5, i = p & 31; const float c = ct[tok * 32 + i], s = st[tok * 32 + i];
            const float x1 = bf2f(pr[C_NQ + head * 64 + i]), x2 = bf2f(pr[C_NQ + head * 64 + i + 32]);
            qr[(size_t)tok * 1024 + head * 64 + i] = (bf16)f2bf(x1 * c - x2 * s); qr[(size_t)tok * 1024 + head * 64 + i + 32] = (bf16)f2bf(x2 * c + x1 * s); }
        const int g = lane >> 5, i = lane & 31; const float c = ct[tok * 32 + i], sn = st[tok * 32 + i];
#pragma unroll
        for (int j = 0; j < 2; ++j) { const int src = (j == 0) ? C_KS : C_KW; bf16* dst = (j == 0) ? ksr : kwr;
            const float x1 = bf2f(pr[src + g * 64 + i]), x2 = bf2f(pr[src + g * 64 + i + 32]);
            dst[(size_t)tok * 128 + g * 64 + i] = (bf16)f2bf(x1 * c - x2 * sn); dst[(size_t)tok * 128 + g * 64 + i + 32] = (bf16)f2bf(x2 * c + x1 * sn); }
        {
            const int b = tok >> 12, t = tok & 4095, jj = t >> 4, tin = t & 15; const size_t rowbase = (size_t)((b * 2 + g) * 256);
            const float k1 = bf2f(pr[C_KC + g * 64 + i]), k2 = bf2f(pr[C_KC + g * 64 + i + 32]);
            const float kr1 = k1 * c - k2 * sn, kr2 = k2 * c + k1 * sn, v1 = bf2f(pr[C_VC + g * 64 + i]), v2 = bf2f(pr[C_VC + g * 64 + i + 32]);
            bf16* cak = (bf16*)(ws + WS_CA); bf16* cav = cak + (size_t)1024 * 2048;
            if (jj <= 254) { const int pp = tin * 64 + i; const size_t o = (rowbase + jj) * 2048 + pp;
                cak[o] = (bf16)f2bf(kr1 + pe[pp]); cak[o + 32] = (bf16)f2bf(kr2 + pe[pp + 32]); cav[o] = (bf16)f2bf(v1 + pe[pp]); cav[o + 32] = (bf16)f2bf(v2 + pe[pp + 32]); }
            if (jj >= 1) { const int pp = (16 + tin) * 64 + i; const size_t o = (rowbase + jj - 1) * 2048 + pp;
                cak[o] = (bf16)f2bf(kr1 + pe[pp]); cak[o + 32] = (bf16)f2bf(kr2 + pe[pp + 32]); cav[o] = (bf16)f2bf(v1 + pe[pp]); cav[o + 32] = (bf16)f2bf(v2 + pe[pp + 32]); }
        }
        if (lane < 48) gate[tok * 48 + lane] = sigmoid_f(bf2f(pr[C_GATE + lane]));
    }
    for (int it = gw; it < 8; it += NGW) {
        bf16* row = (bf16*)(ws + WS_CA) + ((size_t)(it >> 2) * 1024 + (it & 3) * 256 + 255) * 2048;
#pragma unroll
        for (int j = 0; j < 4; ++j) ((GAS v4u*)row)[lane + 64 * j] = (v4u){0u, 0u, 0u, 0u};
    }
}

constexpr int HG_LF = 0, HG_SEGT = 32768, HG_QT = 34816, HG_KT = 52224, HG_QB = 69632, HG_VT = 87040, HG_ATT = 105472, HG_RS = 114688, HG_LB = 115200, HG_END = 115712;
constexpr int P128 = 272, P64 = 144;
DI bf16x8 lds_frag(const LAS unsigned char* p) { return *(const LAS bf16x8*)p; }
#define MFMA16(a, b, c) __builtin_amdgcn_mfma_f32_16x16x32_bf16((a), (b), (c), 0, 0, 0)

DI void hg_load_chunk(const bf16* proj, const float* lbg, LAS unsigned char* lds, int tok0, int h, int tid) {
    LAS float* LF = (LAS float*)(lds + HG_LF); LAS float* LB = (LAS float*)(lds + HG_LB);
    if (tid < 128) LB[tid] = lbg[h * 128 + tid];
    __syncthreads();
#pragma unroll
    for (int j = 0; j < 2; ++j) { const int idx = tid + 512 * j, t = idx >> 4, c8 = idx & 15;
        const bf16* pr = proj + (size_t)(tok0 + t) * DINP + h * 128 + 8 * c8;
        const v4u wf = *(const GAS v4u*)(pr + C_HF), wv = *(const GAS v4u*)(pr + C_HI);
        const unsigned fw[4] = {wf.x, wf.y, wf.z, wf.w}, vw[4] = {wv.x, wv.y, wv.z, wv.w};
#pragma unroll
        for (int e = 0; e < 8; ++e) { const int k = 8 * c8 + e; const float fl = __uint_as_float((e & 1) ? (fw[e >> 1] & 0xffff0000u) : (fw[e >> 1] << 16));
            const float lb = LB[k], f = lb + (1.f - lb) * sigmoid_f(fl);
            LF[t * 128 + k] = __logf(f);
            *(LAS unsigned short*)(lds + HG_VT + k * P64 + 2 * t) = (unsigned short)((e & 1) ? (vw[e >> 1] >> 16) : (vw[e >> 1] & 0xffffu)); }
    }
    __syncthreads();
}
DI void hg_scan_local(LAS unsigned char* lds, int tid) {
    LAS float* LF = (LAS float*)(lds + HG_LF); LAS float* SEGT = (LAS float*)(lds + HG_SEGT);
    const int k = tid & 127, seg = tid >> 7; float s = 0.f;
#pragma unroll
    for (int j = 0; j < 16; ++j) { s += LF[(16 * seg + j) * 128 + k]; LF[(16 * seg + j) * 128 + k] = s; }
    SEGT[seg * 128 + k] = s;
    __syncthreads();
}
DI float exp_c(float x) { return __expf(fminf(x, 80.f)); }

DI void hgrn_a_unit(const AP a, LAS unsigned char* lds, int unit, int tid, int wave, int lane) {
    unsigned char* ws = a.ws_();
    const int bh = unit >> 6, c = unit & 63, b = bh >> 3, h = bh & 7, tok0 = b * SEQ + c * 64;
    hg_load_chunk((const bf16*)(ws + WS_PROJ), (const float*)(ws + WS_LB), lds, tok0, h, tid);
    hg_scan_local(lds, tid);
    {
        LAS float* LF = (LAS float*)(lds + HG_LF); LAS float* SEGT = (LAS float*)(lds + HG_SEGT);
        const int k = tid & 127, seg = tid >> 7;
        const float s0 = SEGT[k], s1 = SEGT[128 + k], s2 = SEGT[256 + k], s3 = SEGT[384 + k];
        const float off = (seg == 0) ? 0.f : (seg == 1) ? s0 : (seg == 2) ? (s0 + s1) : ((s0 + s1) + s2), blast = ((s0 + s1) + s2) + s3;
        float prev = off;
#pragma unroll
        for (int j = 0; j < 16; ++j) { const int t = 16 * seg + j; const float bt = LF[t * 128 + k] + off, f = __expf(bt - prev); prev = bt;
            *(LAS unsigned short*)(lds + HG_QT + k * P64 + 2 * t) = (unsigned short)f2bf((1.f - f) * exp_c(blast - bt)); }
        if (seg == 0) ((float*)(ws + WS_HD))[(size_t)unit * 128 + k] = __expf(blast);
    }
    __syncthreads();
    {
        const int r = lane & 15, q = lane >> 4;
        f32x4 acc[8];
#pragma unroll
        for (int n = 0; n < 8; ++n) acc[n] = (f32x4){0.f, 0.f, 0.f, 0.f};
#pragma unroll
        for (int ks = 0; ks < 2; ++ks) { const bf16x8 av = lds_frag(lds + HG_QT + (16 * wave + r) * P64 + (32 * ks + 8 * q) * 2);
#pragma unroll
            for (int n = 0; n < 8; ++n) acc[n] = MFMA16(av, lds_frag(lds + HG_VT + (16 * n + r) * P64 + (32 * ks + 8 * q) * 2), acc[n]); }
        float* ut = (float*)(ws + WS_UT) + (size_t)unit * 16384;
#pragma unroll
        for (int n = 0; n < 8; ++n) *(f32x4*)(ut + (16 * n + r) * 128 + 16 * wave + 4 * q) = acc[n];
    }
    __syncthreads();
}
DI void hgrn_b_scan(const AP a, int e0, int estride) {
    unsigned char* ws = a.ws_();
    const float* ut = (const float*)(ws + WS_UT); const float* hd = (const float*)(ws + WS_HD); bf16* st = (bf16*)(ws + WS_ST);
    for (int e = e0; e < 16 * 16384; e += estride) { const int bh = e >> 14, vk = e & 16383, k = vk & 127; float s = 0.f;
        const size_t base = (size_t)bh * 64 * 16384 + vk;
#pragma unroll 8
        for (int c = 0; c < 64; ++c) { st[base + (size_t)c * 16384] = (bf16)f2bf(s); s = hd[(bh * 64 + c) * 128 + k] * s + ut[base + (size_t)c * 16384]; }
    }
}
DI void hgrn_c_unit(const AP a, LAS unsigned char* lds, int unit, int tid, int wave, int lane) {
    unsigned char* ws = a.ws_();
    const int bh = unit >> 6, c = unit & 63, b = bh >> 3, h = bh & 7, tok0 = b * SEQ + c * 64;
    const bf16* proj = (const bf16*)(ws + WS_PROJ);
    hg_load_chunk(proj, (const float*)(ws + WS_LB), lds, tok0, h, tid);
    hg_scan_local(lds, tid);
    {
        LAS float* LF = (LAS float*)(lds + HG_LF); LAS float* SEGT = (LAS float*)(lds + HG_SEGT);
        const int k = tid & 127, seg = tid >> 7;
        const float s0 = SEGT[k], s1 = SEGT[128 + k], s2 = SEGT[256 + k];
        const float off = (seg == 0) ? 0.f : (seg == 1) ? s0 : (seg == 2) ? (s0 + s1) : ((s0 + s1) + s2), rr = s0 + s1;
        float prev = off;
#pragma unroll
        for (int j = 0; j < 16; ++j) { const int t = 16 * seg + j; const float bt = LF[t * 128 + k] + off, f = __expf(bt - prev); prev = bt;
            const float qv = bf2f(proj[(size_t)(tok0 + t) * DINP + C_HQ + h * 128 + k]);
            *(LAS unsigned short*)(lds + HG_QT + t * P128 + 2 * k) = (unsigned short)f2bf(qv * exp_c(bt - rr));
            *(LAS unsigned short*)(lds + HG_KT + t * P128 + 2 * k) = (unsigned short)f2bf((1.f - f) * exp_c(rr - bt));
            *(LAS unsigned short*)(lds + HG_QB + t * P128 + 2 * k) = (unsigned short)f2bf(qv * __expf(bt)); }
    }
    __syncthreads();
    const int r = lane & 15, q = lane >> 4, tt = wave >> 1, wh = wave & 1;
    {
#pragma unroll
        for (int si = 0; si < 2; ++si) { const int stile = 2 * wh + si; f32x4 acc = (f32x4){0.f, 0.f, 0.f, 0.f};
            if (stile <= tt) {
#pragma unroll
                for (int ks = 0; ks < 4; ++ks) acc = MFMA16(lds_frag(lds + HG_QT + (16 * tt + r) * P128 + (32 * ks + 8 * q) * 2), lds_frag(lds + HG_KT + (16 * stile + r) * P128 + (32 * ks + 8 * q) * 2), acc);
            }
#pragma unroll
            for (int e = 0; e < 4; ++e) { const int t = 16 * tt + 4 * q + e, s = 16 * stile + r; const float v = (stile <= tt && s <= t) ? acc[e] : 0.f;
                *(LAS unsigned short*)(lds + HG_ATT + t * P64 + 2 * s) = (unsigned short)f2bf(v); }
        }
    }
    __syncthreads();
    {
        f32x4 acc[4];
#pragma unroll
        for (int n = 0; n < 4; ++n) acc[n] = (f32x4){0.f, 0.f, 0.f, 0.f};
#pragma unroll
        for (int ks = 0; ks < 2; ++ks) { const bf16x8 av = lds_frag(lds + HG_ATT + (16 * tt + r) * P64 + (32 * ks + 8 * q) * 2);
#pragma unroll
            for (int n = 0; n < 4; ++n) acc[n] = MFMA16(av, lds_frag(lds + HG_VT + (16 * (4 * wh + n) + r) * P64 + (32 * ks + 8 * q) * 2), acc[n]); }
        const bf16* st = (const bf16*)(ws + WS_ST) + (size_t)unit * 16384;
#pragma unroll
        for (int ks = 0; ks < 4; ++ks) { const bf16x8 av = lds_frag(lds + HG_QB + (16 * tt + r) * P128 + (32 * ks + 8 * q) * 2);
#pragma unroll
            for (int n = 0; n < 4; ++n) { const bf16x8 bv = *(const GAS bf16x8*)(st + (16 * (4 * wh + n) + r) * 128 + 32 * ks + 8 * q); acc[n] = MFMA16(av, bv, acc[n]); } }
        LAS float* RS = (LAS float*)(lds + HG_RS);
        float p[4];
#pragma unroll
        for (int e = 0; e < 4; ++e) { p[e] = (acc[0][e] * acc[0][e] + acc[1][e] * acc[1][e]) + (acc[2][e] * acc[2][e] + acc[3][e] * acc[3][e]);
            p[e] += __shfl_xor(p[e], 1); p[e] += __shfl_xor(p[e], 2); p[e] += __shfl_xor(p[e], 4); p[e] += __shfl_xor(p[e], 8);
            if (r == 0) RS[(16 * tt + 4 * q + e) * 2 + wh] = p[e]; }
        __syncthreads();
        const float* nw = a.in_(10); bf16* omix = (bf16*)(ws + WS_OMIX);
#pragma unroll
        for (int e = 0; e < 4; ++e) { const int t = 16 * tt + 4 * q + e; const float rs = __builtin_amdgcn_rsqf((RS[t * 2] + RS[t * 2 + 1]) * (1.0f / 128.0f) + 1e-6f);
#pragma unroll
            for (int n = 0; n < 4; ++n) { const int v = 16 * (4 * wh + n) + r; const float g = bf2f(proj[(size_t)(tok0 + t) * DINP + C_HG + h * 128 + v]);
                omix[(size_t)(tok0 + t) * DM + h * 128 + v] = (bf16)f2bf(acc[n][e] * rs * nw[h * 128 + v] * silu_f(g)); } }
    }
    __syncthreads();
}
DI void phase_cmp_out(const AP a, int gw, int NGW, int lane) {
    unsigned char* ws = a.ws_();
    for (int it = gw; it < 2 * 1024; it += NGW) {
        const int kv = it >> 10, row = it & 1023; const bf16* hid = (const bf16*)(ws + WS_HID) + (size_t)kv * 262144 + (size_t)row * 256; const float* w2 = a.in_(kv ? 15 : 13);
        float acc = 0.f;
#pragma unroll 8
        for (int j = 0; j < 256; ++j) acc += bf2f(hid[j]) * w2[j * 64 + lane];
        ((bf16*)(ws + (kv ? WS_VC : WS_KC)))[row * 64 + lane] = (bf16)f2bf(acc);
    }
}
typedef float f32x16 __attribute__((ext_vector_type(16)));
typedef float f32x2_t __attribute__((ext_vector_type(2))); typedef __bf16 bf16x2_t __attribute__((ext_vector_type(2)));
typedef unsigned u32x2_t __attribute__((ext_vector_type(2))); typedef unsigned u32x4_t __attribute__((ext_vector_type(4)));
#define MFMA32(a, b, c) __builtin_amdgcn_mfma_f32_32x32x16_bf16((a), (b), (c), 0, 0, 0)
DI unsigned cvtpk_s(float lo, float hi) { f32x2_t v = {lo, hi}; bf16x2_t b = __builtin_convertvector(v, bf16x2_t); return __builtin_bit_cast(unsigned, b); }
DI int crow(int reg, int h) { return (reg & 3) + 8 * (reg >> 2) + 4 * h; }
constexpr float LOG2E = 1.4426950408889634f;
constexpr int AT_KT0 = 0, AT_KT1 = 9216, AT_VT0 = 18432, AT_VT1 = 27648, AT_IMP = 36864, AT_MASKS = 45056, AT_LIST = 45312, AT_OACC = 45824  ;
struct Stg64 { v4u k, v; };
DI Stg64 stg_load64(const bf16* kbase, size_t kpitch, const bf16* vbase, size_t vpitch, int tid) {
    const int key = tid >> 3, ch = tid & 7; Stg64 s; s.k = *(const GAS v4u*)(kbase + (size_t)key * kpitch + ch * 8); s.v = *(const GAS v4u*)(vbase + (size_t)key * vpitch + ch * 8); return s;
}
DI void stg_write64(LAS unsigned char* kt, LAS unsigned char* vt, const Stg64& s, int tid) {
    const int key = tid >> 3, ch = tid & 7;
    *(LAS v4u*)(kt + key * 144 + ch * 16) = s.k;
    const unsigned w[4] = {s.v.x, s.v.y, s.v.z, s.v.w};
#pragma unroll
    for (int e = 0; e < 8; ++e) *(LAS unsigned short*)(vt + (ch * 8 + e) * 144 + key * 2) = (unsigned short)((e & 1) ? (w[e >> 1] >> 16) : (w[e >> 1] & 0xffffu));
}
DI void qk_tile64(f32x16 (&p)[2], const LAS unsigned char* kt, const bf16x8 (&qf)[4], int r, int h) {
#pragma unroll
    for (int kb = 0; kb < 2; ++kb) { f32x16 acc;
#pragma unroll
        for (int i = 0; i < 16; ++i) acc[i] = 0.f;
#pragma unroll
        for (int ks = 0; ks < 4; ++ks) acc = MFMA32(*(const LAS bf16x8*)(kt + (kb * 32 + r) * 144 + (16 * ks + 8 * h) * 2), qf[ks], acc);
        p[kb] = acc; }
}
DI void pv_tile64(f32x16 (&od)[2], const LAS unsigned char* vt, const f32x16 (&p)[2], int r, int h) {
#pragma unroll
    for (int kb = 0; kb < 2; ++kb)
#pragma unroll
        for (int s = 0; s < 2; ++s) {
            u32x4_t pw; pw[0] = cvtpk_s(p[kb][8 * s + 0], p[kb][8 * s + 1]); pw[1] = cvtpk_s(p[kb][8 * s + 2], p[kb][8 * s + 3]); pw[2] = cvtpk_s(p[kb][8 * s + 4], p[kb][8 * s + 5]); pw[3] = cvtpk_s(p[kb][8 * s + 6], p[kb][8 * s + 7]);
            const bf16x8 pf = __builtin_bit_cast(bf16x8, pw);
#pragma unroll
            for (int db = 0; db < 2; ++db) { const LAS unsigned char* vp = vt + (db * 32 + r) * 144 + (kb * 32 + 16 * s + 4 * h) * 2;
                const u32x2_t lo = *(const LAS u32x2_t*)vp, hi = *(const LAS u32x2_t*)(vp + 16);
                u32x4_t vw; vw[0] = lo[0]; vw[1] = lo[1]; vw[2] = hi[0]; vw[3] = hi[1];
                od[db] = MFMA32(__builtin_bit_cast(bf16x8, vw), pf, od[db]); } }
}
DI void softmax_online(f32x16 (&p)[2], float& m, float& l, f32x16 (&od)[2]) {
    float mt = -INFINITY;
#pragma unroll
    for (int kb = 0; kb < 2; ++kb)
#pragma unroll
        for (int i = 0; i < 16; ++i) mt = fmaxf(mt, p[kb][i]);
    mt = fmaxf(mt, __shfl_xor(mt, 32));
    const float mn = fmaxf(m, mt), ms = (mn == -INFINITY) ? 0.f : mn, alpha = __builtin_amdgcn_exp2f(m - ms);
    m = mn;
    float ls = 0.f;
#pragma unroll
    for (int kb = 0; kb < 2; ++kb)
#pragma unroll
        for (int i = 0; i < 16; ++i) { const float e = __builtin_amdgcn_exp2f(p[kb][i] - ms); p[kb][i] = e; ls += e; }
    l = l * alpha + ls;
#pragma unroll
    for (int db = 0; db < 2; ++db)
#pragma unroll
        for (int i = 0; i < 16; ++i) od[db][i] *= alpha;
}
#define TILE_STREAM(NT, KSRC, KPITCH, VSRC, VPITCH, ...) do { const int nt_ = (NT); if (nt_ > 0) { \
    Stg64 sg_; { const int i = 0; (void)i; sg_ = stg_load64(KSRC, KPITCH, VSRC, VPITCH, tid); } \
    stg_write64(lds + AT_KT0, lds + AT_VT0, sg_, tid); __syncthreads(); \
    for (int i_ = 0; i_ < nt_; ++i_) { const int cur_ = i_ & 1; \
        if (i_ + 1 < nt_) { const int i = i_ + 1; (void)i; sg_ = stg_load64(KSRC, KPITCH, VSRC, VPITCH, tid); } \
        { const int i = i_; (void)i; const LAS unsigned char* kt = lds + (cur_ ? AT_KT1 : AT_KT0); const LAS unsigned char* vt = lds + (cur_ ? AT_VT1 : AT_VT0); (void)vt; __VA_ARGS__ } \
        if (i_ + 1 < nt_) stg_write64(lds + (cur_ ? AT_KT0 : AT_KT1), lds + (cur_ ? AT_VT0 : AT_VT1), sg_, tid); \
        __syncthreads(); } } } while (0)

DI void cmp_stats_tile(f32x16 (&p)[2], const LAS unsigned char* kt, const bf16x8 (&qf)[4], int r, int h, int i, int nrow, float c2, float& m, float& l) {
    qk_tile64(p, kt, qf, r, h);
    float mt = -INFINITY;
#pragma unroll
    for (int kb = 0; kb < 2; ++kb)
#pragma unroll
        for (int e = 0; e < 16; ++e) { const int n = 64 * i + 32 * kb + crow(e, h); const float s = (n < nrow) ? p[kb][e] * c2 : -INFINITY; p[kb][e] = s; mt = fmaxf(mt, s); }
    mt = fmaxf(mt, __shfl_xor(mt, 32));
    const float mn = fmaxf(m, mt), ms = (mn == -INFINITY) ? 0.f : mn; float ls = 0.f;
#pragma unroll
    for (int kb = 0; kb < 2; ++kb)
#pragma unroll
        for (int e = 0; e < 16; ++e) ls += __builtin_amdgcn_exp2f(p[kb][e] - ms);
    l = l * __builtin_amdgcn_exp2f(m - ms) + ls; m = mn;
}
DI void cmp_final_tile(f32x16 (&p)[2], f32x16 (&od)[2], const LAS unsigned char* kt, const LAS unsigned char* vt, const bf16x8 (&qf)[4], int r, int h, int i, int nrow, float c2, float ms, float invl, LAS float* IMP, int tl, int hh) {
    qk_tile64(p, kt, qf, r, h);
#pragma unroll
    for (int kb = 0; kb < 2; ++kb)
#pragma unroll
        for (int e = 0; e < 16; ++e) { const int n = 64 * i + 32 * kb + crow(e, h); p[kb][e] = (n < nrow) ? __builtin_amdgcn_exp2f(p[kb][e] * c2 - ms) * invl : 0.f; }
#pragma unroll
    for (int kb = 0; kb < 2; ++kb)
#pragma unroll
        for (int gq = 0; gq < 4; ++gq) { float av = (p[kb][4 * gq] + p[kb][4 * gq + 1]) + (p[kb][4 * gq + 2] + 0.5f * p[kb][4 * gq + 3]), cv = 0.5f * p[kb][4 * gq + 3];
            av += __shfl_xor(av, 1); cv += __shfl_xor(cv, 1); av += __shfl_xor(av, 2); cv += __shfl_xor(cv, 2); av += __shfl_xor(av, 4); cv += __shfl_xor(cv, 4);
            if (hh == 0) { const int j = 16 * i + 8 * kb + 2 * gq + h;
                __hip_atomic_fetch_add(IMP + tl * 64 + j, av, __ATOMIC_RELAXED, __HIP_MEMORY_SCOPE_WORKGROUP);
                if (j < 63) __hip_atomic_fetch_add(IMP + tl * 64 + j + 1, cv, __ATOMIC_RELAXED, __HIP_MEMORY_SCOPE_WORKGROUP); } }
    pv_tile64(od, vt, p, r, h);
}
DI void sel_tile(f32x16 (&p)[2], f32x16 (&od)[2], const LAS unsigned char* kt, const LAS unsigned char* vt, const bf16x8 (&qf)[4], int r, int h, int j, bool sel, int t, float c2, float& m, float& l) {
    qk_tile64(p, kt, qf, r, h);
#pragma unroll
    for (int kb = 0; kb < 2; ++kb)
#pragma unroll
        for (int e = 0; e < 16; ++e) { const int key = 64 * j + 32 * kb + crow(e, h); p[kb][e] = (sel && key <= t) ? p[kb][e] * c2 : -INFINITY; }
    softmax_online(p, m, l, od);
    pv_tile64(od, vt, p, r, h);
}
DI void win_tile(f32x16 (&p)[2], f32x16 (&od)[2], const LAS unsigned char* kt, const LAS unsigned char* vt, const bf16x8 (&qf)[4], int r, int h, int key0, int t, float c2, float& m, float& l) {
    qk_tile64(p, kt, qf, r, h);
#pragma unroll
    for (int kb = 0; kb < 2; ++kb)
#pragma unroll
        for (int e = 0; e < 16; ++e) { const int key = key0 + 32 * kb + crow(e, h); p[kb][e] = (key <= t && key + 511 >= t) ? p[kb][e] * c2 : -INFINITY; }
    softmax_online(p, m, l, od);
    pv_tile64(od, vt, p, r, h);
}

DI void nsa_unit(const AP a, LAS unsigned char* lds, int unit, int tid, int wave, int lane) {
    unsigned char* ws = a.ws_();
    const int bg = unit >> 7, ub = unit & 127, b = bg >> 1, g = bg & 1, t0 = ub * 32, tok0 = b * SEQ + t0;
    const int r = lane & 31, h = lane >> 5, tl = 4 * wave + (r >> 3), hh = r & 7, head = g * 8 + hh, t = t0 + tl, tok = tok0 + tl;
    const bf16* proj = (const bf16*)(ws + WS_PROJ);
    bf16x8 qf[4];
    { const bf16* qp = (const bf16*)(ws + WS_QR) + (size_t)tok * 1024 + head * 64 + 8 * h;
#pragma unroll
      for (int ks = 0; ks < 4; ++ks) qf[ks] = *(const GAS bf16x8*)(qp + 16 * ks); }
    LAS float* IMP = (LAS float*)(lds + AT_IMP); volatile LAS unsigned* MASKS = (volatile LAS unsigned*)(lds + AT_MASKS); volatile LAS int* LIST = (volatile LAS int*)(lds + AT_LIST);
    for (int i = tid; i < 2048; i += NWAVES * 64) IMP[i] = 0.f;
    const float c2 = 0.125f * LOG2E;
    const float* gate = (const float*)(ws + WS_GATE) + (size_t)tok * 48 + head * 3;
    f32x16 od[2]; f32x16 p[2];
    LAS float* OACC = (LAS float*)(lds + AT_OACC) + wave * 2048 + lane;
    {
        const int tmax = t0 + 31; int nv = (tmax >= 31) ? ((tmax - 31) / 16 + 1) : 0; if (nv > 255) nv = 255;
        const int ntc = (nv + 63) >> 6;
        int nrow = (t >= 31) ? ((t - 31) / 16 + 1) : 0; if (nrow > 255) nrow = 255;
        const bf16* kcb = (const bf16*)(ws + WS_KC) + (size_t)bg * 256 * 64; const bf16* vcb = (const bf16*)(ws + WS_VC) + (size_t)bg * 256 * 64;
        float m = -INFINITY, l = 0.f;
#pragma unroll
        for (int db = 0; db < 2; ++db)
#pragma unroll
            for (int i = 0; i < 16; ++i) od[db][i] = 0.f;
        TILE_STREAM(ntc, kcb + (size_t)i * 64 * 64, 64, vcb + (size_t)i * 64 * 64, 64, cmp_stats_tile(p, kt, qf, r, h, i, nrow, c2, m, l););
        l += __shfl_xor(l, 32);
        const float invl = (l > 0.f) ? 1.0f / l : 0.f, ms = (m == -INFINITY) ? 0.f : m;
        TILE_STREAM(ntc, kcb + (size_t)i * 64 * 64, 64, vcb + (size_t)i * 64 * 64, 64, cmp_final_tile(p, od, kt, vt, qf, r, h, i, nrow, c2, ms, invl, IMP, tl, hh););
        const float gc = gate[0];
#pragma unroll
        for (int db = 0; db < 2; ++db)
#pragma unroll
            for (int i = 0; i < 16; ++i) OACC[(16 * db + i) * 64] = gc * od[db][i];
    }
    __syncthreads();
    {
#pragma unroll
        for (int q4 = 0; q4 < 4; ++q4) { const int ti = 4 * wave + q4, tt = t0 + ti, cur = tt >> 6, j = lane;
            const float imp = IMP[ti * 64 + j];
            const bool forced = (j == 0) || (j == cur) || (j == cur - 1), future = j > cur;
            const float score = forced ? INFINITY : (future ? -INFINITY : imp);
            int rank = 0;
#pragma unroll 4
            for (int i = 0; i < 64; ++i) { const float si = __int_as_float(__builtin_amdgcn_readlane(__float_as_int(score), i)); rank += (si > score || (si == score && i < j)) ? 1 : 0; }
            const unsigned long long mk = __ballot(rank < 16);
            if (lane == 0) { MASKS[2 * ti] = (unsigned)mk; MASKS[2 * ti + 1] = (unsigned)(mk >> 32); } }
    }
    __syncthreads();
    unsigned long long mrow, um;
    {
        mrow = (unsigned long long)MASKS[2 * tl] | ((unsigned long long)MASKS[2 * tl + 1] << 32);
        unsigned ulo = MASKS[2 * (lane & 31)], uhi = MASKS[2 * (lane & 31) + 1];
#pragma unroll
        for (int o = 1; o < 32; o <<= 1) { ulo |= __shfl_xor(ulo, o); uhi |= __shfl_xor(uhi, o); }
        um = (unsigned long long)__builtin_amdgcn_readfirstlane(ulo) | ((unsigned long long)__builtin_amdgcn_readfirstlane(uhi) << 32);
        { const int curmax = (t0 + 31) >> 6; if (curmax < 63) um &= (1ull << (curmax + 1)) - 1ull; }
        if (wave == 0) { if ((um >> lane) & 1ull) LIST[__popcll(um & ((1ull << lane) - 1ull))] = lane; }
    }
    __syncthreads();
    {
        const int nsel = __popcll(um);
        const bf16* ksr = (const bf16*)(ws + WS_KSR) + (size_t)b * SEQ * 128 + g * 64; const bf16* vs = proj + (size_t)b * SEQ * DINP + C_VS + g * 64;
        float m = -INFINITY, l = 0.f;
#pragma unroll
        for (int db = 0; db < 2; ++db)
#pragma unroll
            for (int i = 0; i < 16; ++i) od[db][i] = 0.f;
        TILE_STREAM(nsel, ksr + (size_t)(64 * LIST[i]) * 128, 128, vs + (size_t)(64 * LIST[i]) * DINP, DINP, { const int j = LIST[i]; sel_tile(p, od, kt, vt, qf, r, h, j, ((mrow >> j) & 1ull) != 0ull, t, c2, m, l); });
        l += __shfl_xor(l, 32);
        const float sc = gate[1] * ((l > 0.f) ? 1.0f / l : 0.f);
#pragma unroll
        for (int db = 0; db < 2; ++db)
#pragma unroll
            for (int i = 0; i < 16; ++i) OACC[(16 * db + i) * 64] += sc * od[db][i];
    }
    {
        const int tj0 = (t0 >= 511) ? ((t0 - 511) >> 6) : 0, tj1 = (t0 + 31) >> 6, ntw = tj1 - tj0 + 1;
        const bf16* kwr = (const bf16*)(ws + WS_KWR) + ((size_t)b * SEQ + 64 * tj0) * 128 + g * 64; const bf16* vw = proj + ((size_t)b * SEQ + 64 * tj0) * DINP + C_VW + g * 64;
        float m = -INFINITY, l = 0.f;
#pragma unroll
        for (int db = 0; db < 2; ++db)
#pragma unroll
            for (int i = 0; i < 16; ++i) od[db][i] = 0.f;
        TILE_STREAM(ntw, kwr + (size_t)(64 * i) * 128, 128, vw + (size_t)(64 * i) * DINP, DINP, win_tile(p, od, kt, vt, qf, r, h, 64 * (tj0 + i), t, c2, m, l););
        l += __shfl_xor(l, 32);
        const float sc = gate[2] * ((l > 0.f) ? 1.0f / l : 0.f);
#pragma unroll
        for (int db = 0; db < 2; ++db)
#pragma unroll
            for (int i = 0; i < 16; ++i) od[db][i] = OACC[(16 * db + i) * 64] + sc * od[db][i];
    }
    {
        bf16* op = (bf16*)(ws + WS_OMIX) + (size_t)tok * DM + 1024 + head * 64 + 4 * h;
#pragma unroll
        for (int db = 0; db < 2; ++db)
#pragma unroll
            for (int gq = 0; gq < 4; ++gq) { u32x2_t w; w[0] = cvtpk_s(od[db][4 * gq], od[db][4 * gq + 1]); w[1] = cvtpk_s(od[db][4 * gq + 2], od[db][4 * gq + 3]);
                *(GAS u32x2_t*)(op + 32 * db + 8 * gq) = w; }
    }
    __syncthreads();
}

constexpr int XA_KT0 = 0, XA_KT1 = 17408, XA_VT0 = 34816, XA_VT1 = 53248;
struct Stg128 { v4u k[2], v[2]; };
DI Stg128 stg_load128(const bf16* kbase, const bf16* vbase, size_t pitch, int tid) {
    Stg128 s;
#pragma unroll
    for (int j = 0; j < 2; ++j) { const int idx = tid + 512 * j, key = idx >> 4, ch = idx & 15; s.k[j] = *(const GAS v4u*)(kbase + (size_t)key * pitch + ch * 8); s.v[j] = *(const GAS v4u*)(vbase + (size_t)key * pitch + ch * 8); }
    return s;
}
DI void stg_write128(LAS unsigned char* kt, LAS unsigned char* vt, const Stg128& s, int tid) {
#pragma unroll
    for (int j = 0; j < 2; ++j) { const int idx = tid + 512 * j, key = idx >> 4, ch = idx & 15;
        *(LAS v4u*)(kt + key * 272 + ch * 16) = s.k[j];
        const unsigned w[4] = {s.v[j].x, s.v[j].y, s.v[j].z, s.v[j].w};
#pragma unroll
        for (int e = 0; e < 8; ++e) *(LAS unsigned short*)(vt + (ch * 8 + e) * 144 + key * 2) = (unsigned short)((e & 1) ? (w[e >> 1] >> 16) : (w[e >> 1] & 0xffffu)); }
}
DI void xattn_unit(const AP a, LAS unsigned char* lds, int unit, int tid, int wave, int lane) {
    unsigned char* ws = a.ws_();
    const int b = unit >> 6, head = (unit >> 4) & 3, qb = unit & 15, r = lane & 31, h = lane >> 5, tok = b * SEQ + qb * 256 + wave * 32 + r;
    const bf16* kx = (const bf16*)(ws + WS_KVX) + (size_t)b * 256 * 1024 + head * 128; const bf16* vx = kx + 512;
    bf16x8 qf[8];
    { const bf16* qp = (const bf16*)(ws + WS_QX) + (size_t)tok * 512 + head * 128 + 8 * h;
#pragma unroll
      for (int ks = 0; ks < 8; ++ks) qf[ks] = *(const GAS bf16x8*)(qp + 16 * ks); }
    const float c2 = 0.08838834764831845f * LOG2E;
    float m = -INFINITY, l = 0.f; f32x16 od[4], p[2];
#pragma unroll
    for (int db = 0; db < 4; ++db)
#pragma unroll
        for (int i = 0; i < 16; ++i) od[db][i] = 0.f;
    Stg128 sg = stg_load128(kx, vx, 1024, tid);
    stg_write128(lds + XA_KT0, lds + XA_VT0, sg, tid); __syncthreads();
    for (int i = 0; i < 4; ++i) { const int cur = i & 1;
        if (i + 1 < 4) sg = stg_load128(kx + (size_t)(64 * (i + 1)) * 1024, vx + (size_t)(64 * (i + 1)) * 1024, 1024, tid);
        const LAS unsigned char* kt = lds + (cur ? XA_KT1 : XA_KT0); const LAS unsigned char* vt = lds + (cur ? XA_VT1 : XA_VT0);
#pragma unroll
        for (int kb = 0; kb < 2; ++kb) { f32x16 acc;
#pragma unroll
            for (int e = 0; e < 16; ++e) acc[e] = 0.f;
#pragma unroll
            for (int ks = 0; ks < 8; ++ks) acc = MFMA32(*(const LAS bf16x8*)(kt + (kb * 32 + r) * 272 + (16 * ks + 8 * h) * 2), qf[ks], acc);
#pragma unroll
            for (int e = 0; e < 16; ++e) p[kb][e] = acc[e] * c2; }
        {
            float mt = -INFINITY;
#pragma unroll
            for (int kb = 0; kb < 2; ++kb)
#pragma unroll
                for (int e = 0; e < 16; ++e) mt = fmaxf(mt, p[kb][e]);
            mt = fmaxf(mt, __shfl_xor(mt, 32));
            const float mn = fmaxf(m, mt), alpha = __builtin_amdgcn_exp2f(m - mn); m = mn; float ls = 0.f;
#pragma unroll
            for (int kb = 0; kb < 2; ++kb)
#pragma unroll
                for (int e = 0; e < 16; ++e) { const float ev = __builtin_amdgcn_exp2f(p[kb][e] - mn); p[kb][e] = ev; ls += ev; }
            l = l * alpha + ls;
#pragma unroll
            for (int db = 0; db < 4; ++db)
#pragma unroll
                for (int e = 0; e < 16; ++e) od[db][e] *= alpha;
        }
#pragma unroll
        for (int kb = 0; kb < 2; ++kb)
#pragma unroll
            for (int s = 0; s < 2; ++s) {
                u32x4_t pw; pw[0] = cvtpk_s(p[kb][8 * s + 0], p[kb][8 * s + 1]); pw[1] = cvtpk_s(p[kb][8 * s + 2], p[kb][8 * s + 3]); pw[2] = cvtpk_s(p[kb][8 * s + 4], p[kb][8 * s + 5]); pw[3] = cvtpk_s(p[kb][8 * s + 6], p[kb][8 * s + 7]);
                const bf16x8 pf = __builtin_bit_cast(bf16x8, pw);
#pragma unroll
                for (int db = 0; db < 4; ++db) { const LAS unsigned char* vp = vt + (db * 32 + r) * 144 + (kb * 32 + 16 * s + 4 * h) * 2;
                    const u32x2_t lo = *(const LAS u32x2_t*)vp, hi = *(const LAS u32x2_t*)(vp + 16);
                    u32x4_t vw; vw[0] = lo[0]; vw[1] = lo[1]; vw[2] = hi[0]; vw[3] = hi[1];
                    od[db] = MFMA32(__builtin_bit_cast(bf16x8, vw), pf, od[db]); } }
        if (i + 1 < 4) stg_write128(lds + (cur ? XA_KT0 : XA_KT1), lds + (cur ? XA_VT0 : XA_VT1), sg, tid);
        __syncthreads();
    }
    l += __shfl_xor(l, 32);
    const float invl = 1.0f / l;
    bf16* op = (bf16*)(ws + WS_OX) + (size_t)tok * 512 + head * 128 + 4 * h;
#pragma unroll
    for (int db = 0; db < 4; ++db)
#pragma unroll
        for (int gq = 0; gq < 4; ++gq) { u32x2_t w; w[0] = cvtpk_s(od[db][4 * gq] * invl, od[db][4 * gq + 1] * invl); w[1] = cvtpk_s(od[db][4 * gq + 2] * invl, od[db][4 * gq + 3] * invl);
            *(GAS u32x2_t*)(op + 32 * db + 8 * gq) = w; }
}
DI void phase_final_norm(const AP a, int gw, int NGW, int lane) {
    const float* ssq = (const float*)(a.ws_() + WS_SSQ); const float* w = a.in_(27);
    for (int m = gw; m < NTOK; m += NGW) {
        const f32x4* sp = (const f32x4*)(ssq + (size_t)m * 32); float s = 0.f;
#pragma unroll
        for (int j = 0; j < 8; ++j) { const f32x4 v = sp[j]; s += (v[0] + v[1]) + (v[2] + v[3]); }
        const float rs = __builtin_amdgcn_rsqf(s * (1.0f / 2048.0f) + 1e-6f);
        GAS f32x4* xr = (GAS f32x4*)(a.out_() + (size_t)m * DM) + lane;
#pragma unroll
        for (int j = 0; j < 8; ++j) { const f32x4 wv = ((const GAS f32x4*)w)[lane + 64 * j]; xr[64 * j] = xr[64 * j] * rs * wv; }
    }
}

__global__ void __launch_bounds__(NWAVES * 64, 2) mega(Args args) {
    extern __shared__ __attribute__((aligned(16))) unsigned char lds_raw[];
    LAS unsigned char* lds = (LAS unsigned char*)lds_raw;
    volatile LAS unsigned* MISC = (volatile LAS unsigned*)(lds + MISC_OFF);
    const int tid = threadIdx.x, lane = tid & 63, wave = __builtin_amdgcn_readfirstlane(tid >> 6);
    const int G = gridDim.x, bid = blockIdx.x;
    const int gw = bid * NWAVES + wave, NGW = G * NWAVES;
    for (int u = tid; u < (LDS_BYTES - LDSCTL_OFF) / 4; u += NWAVES * 64) ((LAS unsigned*)(lds + LDSCTL_OFF))[u] = 0u;
    __syncthreads();
    const int lo = args.ph_lo, hi = args.ph_hi;
    XcdBarrier bar; bar.bar = (unsigned*)(args.ws + WS_CTL) + CW_BAR; bar.x = 0; bar.st = nullptr;
    if (hi - lo > 1) bar = xcd_barrier_post((unsigned*)(args.ws + WS_CTL) + CW_BAR, MISC + 8);
#define IN(k) (lo <= (k) && (k) < hi)
#define SEAM(k) do { if (IN(k) && IN((k) + 1)) xcd_barrier(bar); } while (0)
#define GEMM_RUN(EPI, g, S, E) pg8::gemm_phase<EPI, pg8::StaticOrder, true, true>(lds + RING_OFF, g, S, E)

    if (IN(0)) { const AP a = make_ap(); phase_prologue(a, lds, gw, NGW, wave, lane); }
    SEAM(0);
    if (IN(1)) {
        const AP a = make_ap(); unsigned char* ws = a.ws_();
        pg8::Gemm g{(const bf16*)(ws + WS_XB), (const bf16*)(ws + WS_WGU), NTOK, 2 * FF, DM}; pg8::StaticOrder S; S.init(NTOK, 2 * FF, G, bid);
        pg8::EpiSwiglu E{(bf16*)(ws + WS_ACT), FF, (const float*)(ws + WS_SSQ)};
        GEMM_RUN(pg8::EpiSwiglu, g, S, E);
    }
    SEAM(1);
    if (IN(2)) {
        const AP a = make_ap(); unsigned char* ws = a.ws_();
        pg8::Gemm g{(const bf16*)(ws + WS_ACT), (const bf16*)(ws + WS_WD), NTOK, DM, FF}; pg8::StaticOrder S; S.init(NTOK, DM, G, bid);
        pg8::EpiResid E{a.in_(0), a.out_(), (bf16*)(ws + WS_XB), (float*)(ws + WS_SSQ), 0.5f};
        GEMM_RUN(pg8::EpiResid, g, S, E);
    }
    SEAM(2);
    if (IN(3)) {
        const AP a = make_ap(); unsigned char* ws = a.ws_();
        pg8::Gemm g{(const bf16*)(ws + WS_XB), (const bf16*)(ws + WS_WIN), NTOK, DINP, DM}; pg8::StaticOrder S; S.init(NTOK, DINP, G, bid);
        pg8::EpiScaleBf16 E{(bf16*)(ws + WS_PROJ), DINP, (const float*)(ws + WS_SSQ)};
        GEMM_RUN(pg8::EpiScaleBf16, g, S, E);
    }
    SEAM(3);
    if (IN(4)) { const AP a = make_ap(); phase_postproj(a, gw, NGW, lane); for (int u = bid; u < 1024; u += G) hgrn_a_unit(a, lds, u, tid, wave, lane); }
    SEAM(4);
    if (IN(5)) {
        if (bid < 8) {
            { const AP a = make_ap(); unsigned char* ws = a.ws_();
              pg8::Gemm g{(const bf16*)(ws + WS_CA), (const bf16*)(ws + WS_W1T), 1024, 256, 2048}; pg8::StaticOrder S; S.init(1024, 256, G, bid);
              pg8::EpiSiluBf16 E{(bf16*)(ws + WS_HID), 256};
              GEMM_RUN(pg8::EpiSiluBf16, g, S, E); }
            { const AP a = make_ap(); unsigned char* ws = a.ws_();
              pg8::Gemm g{(const bf16*)(ws + WS_CA) + (size_t)1024 * 2048, (const bf16*)(ws + WS_W1T) + (size_t)256 * 2048, 1024, 256, 2048}; pg8::StaticOrder S; S.init(1024, 256, G, (bid + G - 4) % G);
              pg8::EpiSiluBf16 E{(bf16*)(ws + WS_HID) + (size_t)1024 * 256, 256};
              GEMM_RUN(pg8::EpiSiluBf16, g, S, E); }
        } else { const AP a = make_ap(); hgrn_b_scan(a, (bid - 8) * (NWAVES * 64) + tid, (G - 8) * (NWAVES * 64)); }
    }
    SEAM(5);
    if (IN(6)) { const AP a = make_ap(); phase_cmp_out(a, gw, NGW, lane); for (int u = bid; u < 1024; u += G) hgrn_c_unit(a, lds, u, tid, wave, lane); }
    SEAM(6);
    if (IN(7)) { const AP a = make_ap(); for (int u = bid; u < 512; u += G) nsa_unit(a, lds, u, tid, wave, lane); }
    SEAM(7);
    if (IN(8)) {
        const AP a = make_ap(); unsigned char* ws = a.ws_();
        pg8::Gemm g{(const bf16*)(ws + WS_OMIX), (const bf16*)(ws + WS_WOUT), NTOK, DM, DM}; pg8::StaticOrder S; S.init(NTOK, DM, G, bid);
        pg8::EpiResid E{a.out_(), a.out_(), (bf16*)(ws + WS_XB), (float*)(ws + WS_SSQ), 1.0f};
        GEMM_RUN(pg8::EpiResid, g, S, E);
    }
    SEAM(8);
    if (IN(9)) {
        { const AP a = make_ap(); unsigned char* ws = a.ws_();
          pg8::Gemm g{(const bf16*)(ws + WS_XB), (const bf16*)(ws + WS_WQ), NTOK, 512, DM}; pg8::StaticOrder S; S.init(NTOK, 512, G, bid);
          pg8::EpiScaleBf16 E{(bf16*)(ws + WS_QX), 512, (const float*)(ws + WS_SSQ)};
          GEMM_RUN(pg8::EpiScaleBf16, g, S, E); }
        { const AP a = make_ap(); unsigned char* ws = a.ws_();
          pg8::Gemm g{(const bf16*)(ws + WS_MEMN), (const bf16*)(ws + WS_WKV), 512, 1024, DM}; pg8::StaticOrder S; S.init(512, 1024, G, (bid + G - 64) % G);
          pg8::EpiScaleBf16 E{(bf16*)(ws + WS_KVX), 1024, nullptr};
          GEMM_RUN(pg8::EpiScaleBf16, g, S, E); }
    }
    SEAM(9);
    if (IN(10)) {
        const AP a = make_ap();
        for (int u = bid; u < 128; u += G) xattn_unit(a, lds, u, tid, wave, lane);
        phase_ffn2_weights(a, lds, gw, NGW, wave, lane);
    }
    SEAM(10);
    if (IN(11)) {
        const AP a = make_ap(); unsigned char* ws = a.ws_();
        pg8::Gemm g{(const bf16*)(ws + WS_OX), (const bf16*)(ws + WS_WO), NTOK, DM, 512}; pg8::StaticOrder S; S.init(NTOK, DM, G, bid);
        pg8::EpiResid E{a.out_(), a.out_(), (bf16*)(ws + WS_XB), (float*)(ws + WS_SSQ), 1.0f};
        GEMM_RUN(pg8::EpiResid, g, S, E);
    }
    SEAM(11);
    if (IN(12)) {
        const AP a = make_ap(); unsigned char* ws = a.ws_();
        pg8::Gemm g{(const bf16*)(ws + WS_XB), (const bf16*)(ws + WS_WGU), NTOK, 2 * FF, DM}; pg8::StaticOrder S; S.init(NTOK, 2 * FF, G, bid);
        pg8::EpiSwiglu E{(bf16*)(ws + WS_ACT), FF, (const float*)(ws + WS_SSQ)};
        GEMM_RUN(pg8::EpiSwiglu, g, S, E);
    }
    SEAM(12);
    if (IN(13)) {
        const AP a = make_ap(); unsigned char* ws = a.ws_();
        pg8::Gemm g{(const bf16*)(ws + WS_ACT), (const bf16*)(ws + WS_WD), NTOK, DM, FF}; pg8::StaticOrder S; S.init(NTOK, DM, G, bid);
        pg8::EpiResid E{a.out_(), a.out_(), nullptr, (float*)(ws + WS_SSQ), 0.5f};
        GEMM_RUN(pg8::EpiResid, g, S, E);
    }
    SEAM(13);
    if (IN(14)) { const AP a = make_ap(); phase_final_norm(a, gw, NGW, lane); }
#undef IN
#undef SEAM
#undef GEMM_RUN
}

extern "C" void kernel_launch(void* const* d_in, const int* in_sizes, int n_in, void* d_out, int out_size, void* d_ws, size_t ws_size, hipStream_t stream) {
    static int grid = 0;
    if (grid == 0) {
        if (n_in != 28 || in_sizes[0] != NTOK * DM || out_size != NTOK * DM || ws_size < WS_END) { fprintf(stderr, "kernel_launch: unexpected shapes / workspace (n_in %d, ws %zu); nothing launched\n", n_in, ws_size); grid = -1; return; }
        int dev = 0, cus = 0;
        if (hipGetDevice(&dev) != hipSuccess || hipDeviceGetAttribute(&cus, hipDeviceAttributeMultiprocessorCount, dev) != hipSuccess) { grid = -1; return; }
        if (hipFuncSetAttribute((const void*)mega, hipFuncAttributeMaxDynamicSharedMemorySize, LDS_BYTES) != hipSuccess) { fprintf(stderr, "kernel_launch: hipFuncSetAttribute failed\n"); grid = -1; return; }
        (void)hipGetLastError();
        grid = cus;
    }
    if (grid < 0) return;
    if (hipMemsetAsync((char*)d_ws + WS_CTL, 0, CTL_ZERO_BYTES, stream) != hipSuccess) return;
    Args a{};
    for (int i = 0; i < 28; ++i) a.in[i] = (const float*)d_in[i];
    a.out = (float*)d_out; a.ws = (unsigned char*)d_ws;
#if MK_ONE_LAUNCH
    a.ph_lo = 0; a.ph_hi = NPH;
    hipLaunchKernelGGL(mega, dim3(grid), dim3(NWAVES * 64), LDS_BYTES, stream, a);
#else
    for (int k = 0; k < NPH; ++k) { a.ph_lo = k; a.ph_hi = k + 1; hipLaunchKernelGGL(mega, dim3(grid), dim3(NWAVES * 64), LDS_BYTES, stream, a); }
#endif
}
```

```cpp
#include <hip/hip_runtime.h>
#include <cstdio>
#include <cstdint>
namespace pg8 {
#define PG8_LAS __attribute__((address_space(3)))
typedef unsigned short bf16_t;
typedef short bf16x8 __attribute__((ext_vector_type(8)));
typedef float f32x4 __attribute__((ext_vector_type(4)));
typedef unsigned u32x4 __attribute__((ext_vector_type(4)));
typedef unsigned u32x2 __attribute__((ext_vector_type(2)));
constexpr int BM = 256, BK = 64, HALF = 128, HTB = HALF * BK * 2  , STAGE_BYTES = 8 * HTB, NXCD = 8, WGM = 8;

__host__ __device__ __forceinline__ int lds_byte(int r, int c) { const int st = (r >> 4) * 2 + (c >> 5), rr = r & 15, cc = c & 31, ob = rr * 64 + cc * 2; return st * 1024 + (ob ^ (((ob >> 9) & 1) << 5)); }
__host__ __device__ __forceinline__ void stage_rc(int b, int& R, int& C) { const int st = b / 1024, sb = b % 1024, swz = sb ^ (((sb >> 9) & 1) << 5); R = (st >> 1) * 16 + swz / 64; C = (st & 1) * 32 + (swz % 64) / 2; }
__host__ __device__ __forceinline__ int perm32(int rho) { const int n = rho >> 4, i = rho & 15; return 8 * (i >> 2) + 4 * n + (i & 3); }

struct Unit { int pm, pn; };
struct Gemm { const bf16_t* A; const bf16_t* Bt; int M, N, K; };

struct StaticOrder {
    int nM, nN, nwg, G, c;
    __host__ __device__ void init(int M, int N, int G_, int c_) { nM = M / BM; nN = N / BM; nwg = nM * nN; G = G_; c = c_; }
    __host__ __device__ bool next(int i, Unit& u) const {
        const long L = (long)i * G + c; if (L >= nwg) return false;
        int wgid = (int)L; { const int q = nwg / NXCD, r = nwg % NXCD, xcd = wgid % NXCD, off = wgid / NXCD; wgid = (xcd < r ? xcd * (q + 1) : r * (q + 1) + (xcd - r) * q) + off; }
        const int nig = WGM * nN, gid = wgid / nig, fm = gid * WGM, gsz = (nM - fm) < WGM ? (nM - fm) : WGM;
        u.pm = fm + ((wgid % nig) % gsz); u.pn = (wgid % nig) / gsz; return true;
    }
    __device__ __forceinline__ void a_ready(const Unit&) const {}
    __device__ __forceinline__ void done(const Unit&) const {}
};

__device__ __forceinline__ unsigned cvt_pk_bf16(float lo, float hi) { unsigned r; asm volatile("v_cvt_pk_bf16_f32 %0, %1, %2" : "=v"(r) : "v"(lo), "v"(hi)); return r; }

__device__ __forceinline__ float row_rstd(const float* ssq, int row, int fq) {
    const f32x4* p = (const f32x4*)(ssq + (size_t)row * 32 + 8 * fq);
    const f32x4 a = p[0], b = p[1];
    float s = ((a[0] + a[1]) + (a[2] + a[3])) + ((b[0] + b[1]) + (b[2] + b[3]));
    s += __shfl_xor(s, 16); s += __shfl_xor(s, 32);
    return __builtin_amdgcn_rsqf(s * (1.0f / 2048.0f) + 1e-6f);
}
__device__ __forceinline__ void rows_rstd(float (&rs)[2][4], const float* ssq, int row0, int fq, float mul) {
    f32x4 a[2][4], b[2][4];
#pragma unroll
    for (int ai = 0; ai < 2; ++ai)
#pragma unroll
        for (int m = 0; m < 4; ++m) { const f32x4* p = (const f32x4*)(ssq + (size_t)(row0 + ai * HALF + m * 16) * 32 + 8 * fq); a[ai][m] = p[0]; b[ai][m] = p[1]; }
#pragma unroll
    for (int ai = 0; ai < 2; ++ai)
#pragma unroll
        for (int m = 0; m < 4; ++m) { const f32x4 x = a[ai][m], y = b[ai][m];
            float s = ((x[0] + x[1]) + (x[2] + x[3])) + ((y[0] + y[1]) + (y[2] + y[3]));
            s += __shfl_xor(s, 16); s += __shfl_xor(s, 32);
            rs[ai][m] = __builtin_amdgcn_rsqf(s * (1.0f / 2048.0f) + 1e-6f) * mul; }
}
__device__ __forceinline__ float silu_f(float x) { return x * __builtin_amdgcn_rcpf(1.0f + __expf(-x)); }

struct EpiScaleBf16 {
    static constexpr bool PERM = true, AFTER_DRAIN = false;
    bf16_t* O; int ldc; const float* ssq; float mul;
    __device__ __forceinline__ void operator()(const f32x4 (&acc)[2][2][4][2], const Unit& u, int wr, int wc, int fr, int fq) const {
        const int row0 = u.pm * BM + wr * 64 + fr, col0 = u.pn * BM + wc * 32 + 8 * fq;
        float rsv[2][4];
        if (ssq) rows_rstd(rsv, ssq, row0, fq, mul);
        else {
#pragma unroll
            for (int ai = 0; ai < 2; ++ai)
#pragma unroll
                for (int m = 0; m < 4; ++m) rsv[ai][m] = mul; }
#pragma unroll
        for (int ai = 0; ai < 2; ++ai)
#pragma unroll
            for (int m = 0; m < 4; ++m) { const int row = row0 + ai * HALF + m * 16; const float rs = rsv[ai][m];
                bf16_t* rowp = O + (size_t)row * ldc + col0;
#pragma unroll
                for (int bj = 0; bj < 2; ++bj) { const f32x4 v0 = acc[ai][bj][m][0] * rs, v1 = acc[ai][bj][m][1] * rs;
                    u32x4 w; w.x = cvt_pk_bf16(v0[0], v0[1]); w.y = cvt_pk_bf16(v0[2], v0[3]); w.z = cvt_pk_bf16(v1[0], v1[1]); w.w = cvt_pk_bf16(v1[2], v1[3]);
                    *(u32x4*)(rowp + bj * HALF) = w; } }
    }
};
struct EpiNull {
    static constexpr bool PERM = true, AFTER_DRAIN = false;
    float* sink;
    __device__ __forceinline__ void operator()(const f32x4 (&acc)[2][2][4][2], const Unit& u, int wr, int wc, int fr, int fq) const {
        f32x4 s = {0.f, 0.f, 0.f, 0.f};
#pragma unroll
        for (int ai = 0; ai < 2; ++ai)
#pragma unroll
            for (int bj = 0; bj < 2; ++bj)
#pragma unroll
                for (int m = 0; m < 4; ++m)
#pragma unroll
                    for (int n = 0; n < 2; ++n) s += acc[ai][bj][m][n];
        if (s[0] + s[1] + s[2] + s[3] == 123456.789f) sink[0] = s[0];
    }
};
struct EpiSiluBf16 {
    static constexpr bool PERM = true, AFTER_DRAIN = false;
    bf16_t* O; int ldc;
    __device__ __forceinline__ void operator()(const f32x4 (&acc)[2][2][4][2], const Unit& u, int wr, int wc, int fr, int fq) const {
        const int row0 = u.pm * BM + wr * 64 + fr, col0 = u.pn * BM + wc * 32 + 8 * fq;
#pragma unroll
        for (int ai = 0; ai < 2; ++ai)
#pragma unroll
            for (int m = 0; m < 4; ++m) { bf16_t* rowp = O + (size_t)(row0 + ai * HALF + m * 16) * ldc + col0;
#pragma unroll
                for (int bj = 0; bj < 2; ++bj) { const f32x4 v0 = acc[ai][bj][m][0], v1 = acc[ai][bj][m][1];
                    u32x4 w; w.x = cvt_pk_bf16(silu_f(v0[0]), silu_f(v0[1])); w.y = cvt_pk_bf16(silu_f(v0[2]), silu_f(v0[3])); w.z = cvt_pk_bf16(silu_f(v1[0]), silu_f(v1[1])); w.w = cvt_pk_bf16(silu_f(v1[2]), silu_f(v1[3]));
                    *(u32x4*)(rowp + bj * HALF) = w; } }
    }
};
struct EpiSwiglu {
    static constexpr bool PERM = true, AFTER_DRAIN = false;
    bf16_t* O; int ldc; const float* ssq;
    __device__ __forceinline__ void operator()(const f32x4 (&acc)[2][2][4][2], const Unit& u, int wr, int wc, int fr, int fq) const {
        const int row0 = u.pm * BM + wr * 64 + fr, col0 = u.pn * HALF + wc * 32 + 8 * fq;
        float rsv[2][4];
        rows_rstd(rsv, ssq, row0, fq, 1.0f);
#pragma unroll
        for (int ai = 0; ai < 2; ++ai)
#pragma unroll
            for (int m = 0; m < 4; ++m) { const int row = row0 + ai * HALF + m * 16; const float rs = rsv[ai][m];
                const f32x4 g0 = acc[ai][0][m][0] * rs, g1 = acc[ai][0][m][1] * rs, u0 = acc[ai][1][m][0] * rs, u1 = acc[ai][1][m][1] * rs;
                f32x4 a0, a1;
#pragma unroll
                for (int i = 0; i < 4; ++i) { a0[i] = silu_f(g0[i]) * u0[i]; a1[i] = silu_f(g1[i]) * u1[i]; }
                u32x4 w; w.x = cvt_pk_bf16(a0[0], a0[1]); w.y = cvt_pk_bf16(a0[2], a0[3]); w.z = cvt_pk_bf16(a1[0], a1[1]); w.w = cvt_pk_bf16(a1[2], a1[3]);
                *(u32x4*)(O + (size_t)row * ldc + col0) = w; }
    }
};
struct EpiResid {
    static constexpr bool PERM = false, AFTER_DRAIN = false;
    const float* base; float* out; bf16_t* xb; float* ssq_out; float scale;
    __device__ __forceinline__ void operator()(const f32x4 (&acc)[2][2][4][2], const Unit& u, int wr, int wc, int fr, int fq) const {
        const int row0 = u.pm * BM + wr * 64 + fr, col0 = u.pn * BM + wc * 32 + 4 * fq;
#pragma unroll
        for (int ai = 0; ai < 2; ++ai)
#pragma unroll
            for (int m = 0; m < 4; ++m) { const int row = row0 + ai * HALF + m * 16; const size_t off = (size_t)row * 2048 + col0; float ss = 0.f;
#pragma unroll
                for (int bj = 0; bj < 2; ++bj)
#pragma unroll
                    for (int n = 0; n < 2; ++n) { const size_t c = off + bj * HALF + n * 16; const f32x4 b = *(const f32x4*)(base + c); const f32x4 v = b + acc[ai][bj][m][n] * scale;
                        *(f32x4*)(out + c) = v; ss += (v[0] * v[0] + v[1] * v[1]) + (v[2] * v[2] + v[3] * v[3]);
                        if (xb) { u32x2 w; w.x = cvt_pk_bf16(v[0], v[1]); w.y = cvt_pk_bf16(v[2], v[3]); *(u32x2*)(xb + c) = w; } }
                ss += __shfl_xor(ss, 16); ss += __shfl_xor(ss, 32);
                if (fq == 0) ssq_out[(size_t)row * 32 + u.pn * 4 + wc] = ss; }
    }
};

template <class Epi, class Sched, bool ALIGN_EPI = false, bool SP2 = false>
__device__ __forceinline__ void gemm_phase(PG8_LAS unsigned char* lds, const Gemm g, const Sched& S, const Epi& E) {
    int tid_ = threadIdx.x; asm volatile("" : "+v"(tid_));
    const int tid = tid_, wid = __builtin_amdgcn_readfirstlane(tid >> 6), lane = tid & 63, wr = wid >> 2, wc = wid & 3, fr = lane & 15, fq = lane >> 4;
    const int K = g.K, nt = K / BK;
    unsigned voffA[2], voffB[2];
#pragma unroll
    for (int i = 0; i < 2; ++i) { int R, C; stage_rc(tid * 16 + i * 8192, R, C); const int Rb = Epi::PERM ? ((R & ~31) + perm32(R & 31)) : R;
        voffA[i] = (unsigned)(R * K + C) * 2u; voffB[i] = (unsigned)(Rb * K + C) * 2u; }
    const size_t kstep = (size_t)(BK * 2);
    const size_t hstep = (size_t)HALF * K * 2;
    const size_t tstep = 2 * hstep;
    const unsigned ldsw = (unsigned)wid * 1024u;
    const int aoff = lds_byte(wr * 64 + fr, fq * 8), boff = lds_byte(wc * 32 + fr, fq * 8);
#define PG8_SA(b, h) (((b) * 2 + (h)) * HTB)
#define PG8_SB(b, h) ((4 + (b) * 2 + (h)) * HTB)
#define PG8_STAGE(bufoff, gbase, voff) do { _Pragma("unroll") for (int _i = 0; _i < 2; ++_i) \
        __builtin_amdgcn_global_load_lds((const unsigned*)((const char*)(gbase) + (voff)[_i]), (PG8_LAS unsigned*)(lds + (bufoff) + ldsw + _i * 8192), 16, 0, 0); } while (0)
#define PG8_LDA(dst, b, h) do { _Pragma("unroll") for (int m = 0; m < 4; ++m) _Pragma("unroll") for (int k = 0; k < 2; ++k) dst[m][k] = *(const PG8_LAS bf16x8*)(lds + PG8_SA(b, h) + aoff + m * 2048 + k * 1024); } while (0)
#define PG8_LDB(dst, b, h) do { _Pragma("unroll") for (int n = 0; n < 2; ++n) _Pragma("unroll") for (int k = 0; k < 2; ++k) dst[n][k] = *(const PG8_LAS bf16x8*)(lds + PG8_SB(b, h) + boff + n * 2048 + k * 1024); } while (0)
#define PG8_MMA(ai, bj, At, Bt) do { __builtin_amdgcn_s_setprio(1); _Pragma("unroll") for (int m = 0; m < 4; ++m) _Pragma("unroll") for (int n = 0; n < 2; ++n) _Pragma("unroll") for (int k = 0; k < 2; ++k) \
        acc[ai][bj][m][n] = __builtin_amdgcn_mfma_f32_16x16x32_bf16(Bt[n][k], At[m][k], acc[ai][bj][m][n], 0, 0, 0); __builtin_amdgcn_s_setprio(0); } while (0)
#define PG8_WAIT_V(n) asm volatile("s_waitcnt vmcnt(" #n ")" ::: "memory")
#define PG8_WAIT_L(n) asm volatile("s_waitcnt lgkmcnt(" #n ")" ::: "memory")
#define PG8_BAR __builtin_amdgcn_s_barrier()
#define PG8_SCHED __builtin_amdgcn_sched_barrier(0)
    Unit cur, nxt; int ui = 0;
    if (!S.next(0, cur)) return;
    f32x4 acc[2][2][4][2];
#pragma unroll
    for (int a = 0; a < 2; ++a)
#pragma unroll
        for (int b = 0; b < 2; ++b)
#pragma unroll
            for (int m = 0; m < 4; ++m)
#pragma unroll
                for (int n = 0; n < 2; ++n) acc[a][b][m][n] = (f32x4){0.f, 0.f, 0.f, 0.f};
    bf16x8 At[4][2], B0[2][2], B1[2][2];
    const char* cA = (const char*)g.A + (size_t)cur.pm * tstep; const char* cB = (const char*)g.Bt + (size_t)cur.pn * tstep;
    S.a_ready(cur);
    if constexpr (SP2) {
        PG8_STAGE(PG8_SB(0, 0), cB, voffB); PG8_STAGE(PG8_SB(0, 1), cB + hstep, voffB); PG8_STAGE(PG8_SA(0, 0), cA, voffA); PG8_STAGE(PG8_SA(0, 1), cA + hstep, voffA);
        if (wr == 1) PG8_BAR;
        PG8_WAIT_V(2); PG8_BAR;
        PG8_STAGE(PG8_SB(1, 0), cB + kstep, voffB); PG8_STAGE(PG8_SA(1, 0), cA + kstep, voffA); PG8_STAGE(PG8_SB(1, 1), cB + hstep + kstep, voffB);
        PG8_WAIT_V(6); PG8_BAR;
    } else {
        PG8_STAGE(PG8_SB(0, 0), cB, voffB); PG8_STAGE(PG8_SA(0, 0), cA, voffA); PG8_STAGE(PG8_SB(0, 1), cB + hstep, voffB); PG8_STAGE(PG8_SA(0, 1), cA + hstep, voffA);
        if (wr == 1) PG8_BAR;
        PG8_WAIT_V(4); PG8_BAR;
        PG8_STAGE(PG8_SB(1, 0), cB + kstep, voffB); PG8_STAGE(PG8_SA(1, 0), cA + kstep, voffA); PG8_STAGE(PG8_SB(1, 1), cB + hstep + kstep, voffB);
        PG8_WAIT_V(6); PG8_BAR;
    }
    for (;;) {
        const bool has_next = S.next(ui + 1, nxt);
        const char* nA = has_next ? (const char*)g.A + (size_t)nxt.pm * tstep : cA; const char* nB = has_next ? (const char*)g.Bt + (size_t)nxt.pn * tstep : cB;
        for (int t = 0; t < nt; t += 2) {
            const bool last = (t == nt - 2);
            const char* a1 = cA + (size_t)(t + 1) * kstep;
            const char* a2 = last ? nA : cA + (size_t)(t + 2) * kstep; const char* b2 = last ? nB : cB + (size_t)(t + 2) * kstep;
            const char* a3 = a2 + kstep; const char* b3 = b2 + kstep;
            if (last && has_next) S.a_ready(nxt);
            if constexpr (SP2) {
            PG8_LDB(B0, 0, 0); PG8_LDB(B1, 0, 1); PG8_SCHED; PG8_LDA(At, 0, 0); PG8_STAGE(PG8_SA(1, 1), a1 + hstep, voffA);
            PG8_WAIT_V(8); PG8_WAIT_L(0); PG8_BAR; PG8_MMA(0, 0, At, B0); PG8_MMA(0, 1, At, B1); PG8_BAR; PG8_SCHED;
            PG8_LDA(At, 0, 1); PG8_STAGE(PG8_SB(0, 0), b2, voffB); PG8_STAGE(PG8_SB(0, 1), b2 + hstep, voffB); PG8_STAGE(PG8_SA(0, 0), a2, voffA);
            PG8_WAIT_V(8); PG8_WAIT_L(0); PG8_BAR; PG8_MMA(1, 0, At, B0); PG8_MMA(1, 1, At, B1); PG8_BAR; PG8_SCHED;
            PG8_LDB(B0, 1, 0); PG8_LDB(B1, 1, 1); PG8_SCHED; PG8_LDA(At, 1, 0); PG8_STAGE(PG8_SA(0, 1), a2 + hstep, voffA);
            PG8_WAIT_V(8); PG8_WAIT_L(0); PG8_BAR; PG8_MMA(0, 0, At, B0); PG8_MMA(0, 1, At, B1); PG8_BAR; PG8_SCHED;
            PG8_LDA(At, 1, 1); PG8_STAGE(PG8_SB(1, 0), b3, voffB); PG8_STAGE(PG8_SB(1, 1), b3 + hstep, voffB); PG8_STAGE(PG8_SA(1, 0), a3, voffA);
            PG8_WAIT_V(8); PG8_WAIT_L(0); PG8_BAR; PG8_MMA(1, 0, At, B0); PG8_MMA(1, 1, At, B1); PG8_BAR; PG8_SCHED;
            } else {
            PG8_LDB(B0, 0, 0); PG8_SCHED; PG8_LDA(At, 0, 0); PG8_STAGE(PG8_SA(1, 1), a1 + hstep, voffA);
            PG8_WAIT_L(8); PG8_BAR; PG8_WAIT_L(0); PG8_MMA(0, 0, At, B0); PG8_BAR; PG8_SCHED;
            PG8_LDB(B1, 0, 1); PG8_STAGE(PG8_SB(0, 0), b2, voffB);
            PG8_BAR; PG8_WAIT_L(0); PG8_MMA(0, 1, At, B1); PG8_BAR;
            PG8_LDA(At, 0, 1); PG8_STAGE(PG8_SA(0, 0), a2, voffA);
            PG8_BAR; PG8_WAIT_L(0); PG8_MMA(1, 0, At, B0); PG8_BAR; PG8_SCHED;
            PG8_STAGE(PG8_SB(0, 1), b2 + hstep, voffB);
            PG8_WAIT_V(6); PG8_BAR; PG8_MMA(1, 1, At, B1); PG8_BAR;
            PG8_LDB(B0, 1, 0); PG8_SCHED; PG8_LDA(At, 1, 0); PG8_STAGE(PG8_SA(0, 1), a2 + hstep, voffA);
            PG8_WAIT_L(8); PG8_BAR; PG8_WAIT_L(0); PG8_MMA(0, 0, At, B0); PG8_BAR; PG8_SCHED;
            PG8_LDB(B1, 1, 1); PG8_STAGE(PG8_SB(1, 0), b3, voffB);
            PG8_BAR; PG8_WAIT_L(0); PG8_MMA(0, 1, At, B1); PG8_BAR;
            PG8_LDA(At, 1, 1); PG8_STAGE(PG8_SA(1, 0), a3, voffA);
            PG8_BAR; PG8_WAIT_L(0); PG8_MMA(1, 0, At, B0); PG8_BAR; PG8_SCHED;
            PG8_STAGE(PG8_SB(1, 1), b3 + hstep, voffB);
            PG8_WAIT_V(6); PG8_BAR; PG8_MMA(1, 1, At, B1); PG8_BAR;
            }
        }
        if constexpr (ALIGN_EPI) { if (wr == 0) PG8_BAR; }
        if constexpr (!Epi::AFTER_DRAIN) { E(acc, cur, wr, wc, fr, fq); S.done(cur); }
        if (!has_next) break;
#pragma unroll
        for (int a = 0; a < 2; ++a)
#pragma unroll
            for (int b = 0; b < 2; ++b)
#pragma unroll
                for (int m = 0; m < 4; ++m)
#pragma unroll
                    for (int n = 0; n < 2; ++n) acc[a][b][m][n] = (f32x4){0.f, 0.f, 0.f, 0.f};
        cur = nxt; cA = nA; cB = nB; ++ui;
        if constexpr (ALIGN_EPI) { if (wr == 1) PG8_BAR; }
    }
    PG8_WAIT_V(0);
    if constexpr (!ALIGN_EPI) { if (wr == 0) PG8_BAR; }
    PG8_BAR;
    if constexpr (Epi::AFTER_DRAIN) { E.fused(acc, cur, wr, wc, fr, fq, lds, wid, lane); S.done(cur); }
#undef PG8_SA
#undef PG8_SB
#undef PG8_STAGE
#undef PG8_LDA
#undef PG8_LDB
#undef PG8_MMA
#undef PG8_WAIT_V
#undef PG8_WAIT_L
#undef PG8_BAR
#undef PG8_SCHED
}
}
#define GAS __attribute__((address_space(1)))
#define LAS __attribute__((address_space(3)))
typedef unsigned short bf16;
typedef unsigned v4u __attribute__((ext_vector_type(4)));
typedef float f32x4 __attribute__((ext_vector_type(4)));
typedef short bf16x8 __attribute__((ext_vector_type(8)));
typedef GAS unsigned gu32;
typedef GAS unsigned long long gu64;
#define RLX_AGENT __ATOMIC_RELAXED, __HIP_MEMORY_SCOPE_AGENT
#define LDS_WAIT() asm volatile("s_waitcnt lgkmcnt(0)" ::: "memory")
#define VM_WAIT() asm volatile("s_waitcnt vmcnt(0)" ::: "memory")
__device__ __forceinline__ unsigned long long rt() { return __builtin_amdgcn_s_memrealtime(); }
__device__ __forceinline__ unsigned f2bf(float f) { unsigned u = __builtin_bit_cast(unsigned, f); return (u + 0x7fffu + ((u >> 16) & 1u)) >> 16; }
__device__ __forceinline__ unsigned pk2(float lo, float hi) { return f2bf(lo) | (f2bf(hi) << 16); }

#define XB_TMO      128
#define XB_XCNT(j)  (256  + 64 * (j))
#define XB_XSUB(j)  (1280 + 64 * (j))
#define XB_XGEN(j)  (2304 + 64 * (j))
#define XB_TOP      3328
#define XB_TOPGEN   3392
#define XCD_BAR_WORDS 3456
#define XB_SPIN_CAP (1u << 18)

__device__ __forceinline__ unsigned xb_ld(unsigned* p)              { return __hip_atomic_load(p, __ATOMIC_RELAXED, __HIP_MEMORY_SCOPE_AGENT); }
__device__ __forceinline__ unsigned xb_add(unsigned* p, unsigned v) { return __hip_atomic_fetch_add(p, v, __ATOMIC_RELAXED, __HIP_MEMORY_SCOPE_AGENT); }
__device__ __forceinline__ unsigned xb_xcc_id() { return (unsigned)__builtin_amdgcn_s_getreg((3 << 11) | 20) & 0xFu; }
#define XB_SPIN(cond, bar) do { unsigned _sp = 0; while (cond) { __builtin_amdgcn_s_sleep(1); \
    if ((++_sp & 255u) == 0u) { if (xb_ld(&(bar)[XB_TMO])) break; if (_sp > XB_SPIN_CAP) { atomicAdd(&(bar)[XB_TMO], 1u); break; } } } } while (0)

struct XcdBarrier {
    unsigned* bar; unsigned x;
    volatile LAS unsigned* st;
};

__device__ __forceinline__ XcdBarrier xcd_barrier_post(unsigned* bar, volatile LAS unsigned* st) {
    XcdBarrier b; b.bar = bar; b.x = xb_xcc_id(); b.st = st;
    if (threadIdx.x == 0) (void)xb_add(&bar[XB_XCNT(b.x)], 1u);
    return b;
}
__device__ __forceinline__ void xcd_barrier_complete(unsigned* bar, unsigned x, unsigned& nloc, unsigned& nx) {
    const unsigned G = gridDim.x * gridDim.y * gridDim.z;
    unsigned sum, cnt, mine, sp = 0u;
    for (;;) {
        sum = 0u; cnt = 0u; mine = 0u;
#pragma unroll
        for (unsigned j = 0; j < 16; ++j) { const unsigned c = xb_ld(&bar[XB_XCNT(j)]); sum += c; cnt += (c > 0u) ? 1u : 0u; mine = (j == x) ? c : mine; }
        if (sum == G) break;
        __builtin_amdgcn_s_sleep(1);
        if ((++sp & 255u) == 0u) { if (xb_ld(&bar[XB_TMO])) break; if (sp > XB_SPIN_CAP) { atomicAdd(&bar[XB_TMO], 1u); break; } }
    }
    nloc = mine > 0u ? mine : 1u; nx = cnt > 0u ? cnt : 1u;
}

__device__ __forceinline__ void xcd_barrier(const XcdBarrier& b) {
    asm volatile("s_waitcnt vmcnt(0)" ::: "memory");
    __syncthreads();
    if (threadIdx.x == 0) {
        unsigned* bar = b.bar;
        __builtin_amdgcn_s_waitcnt(0);
        unsigned nloc = b.st[0], nx = b.st[1];
        if (nloc == 0u) { xcd_barrier_complete(bar, b.x, nloc, nx); b.st[0] = nloc; b.st[1] = nx; }
        const unsigned old = xb_add(&bar[XB_XSUB(b.x)], 1u);
        const unsigned gen = old / nloc;
        if (old + 1u == (gen + 1u) * nloc) {
            __builtin_amdgcn_fence(__ATOMIC_RELEASE, "agent");
            asm volatile("s_waitcnt vmcnt(0)" ::: "memory");
            const unsigned og = xb_add(&bar[XB_TOP], 1u);
            const unsigned tg = og / nx;
            if (og + 1u == (tg + 1u) * nx) xb_add(&bar[XB_TOPGEN], 1u);
            else XB_SPIN(xb_ld(&bar[XB_TOPGEN]) == tg, bar);
            __builtin_amdgcn_fence(__ATOMIC_ACQUIRE, "agent");
            xb_add(&bar[XB_XGEN(b.x)], 1u);
            asm volatile("s_waitcnt vmcnt(0)" ::: "memory");
        } else {
            XB_SPIN(xb_ld(&bar[XB_XGEN(b.x)]) == gen, bar);
            __builtin_amdgcn_fence(__ATOMIC_ACQUIRE, "agent");
            asm volatile("s_waitcnt vmcnt(0)" ::: "memory");
        }
    }
    __syncthreads();
}

constexpr int NTOK = 8192, SEQ = 4096, DM = 2048, FF = 5632, DIN = 5936, DINP = 6144;
constexpr int C_HQ = 0, C_HF = 1024, C_HI = 2048, C_HG = 3072, C_NQ = 4096, C_KC = 5120, C_VC = 5248, C_KS = 5376, C_VS = 5504, C_KW = 5632, C_VW = 5760, C_GATE = 5888;
constexpr int NPH = 15;
#ifndef MK_ONE_LAUNCH
#define MK_ONE_LAUNCH 1
#endif
constexpr int NWAVES = 8;
constexpr size_t MiB = 1u << 20;
constexpr size_t WS_CTL = 0, CTL_ZERO_BYTES = 1 * MiB;
constexpr size_t WS_SSQ = 1 * MiB, WS_COS = 2 * MiB, WS_SIN = 3 * MiB, WS_LB = 4 * MiB, WS_KC = 4 * MiB + 65536, WS_VC = WS_KC + 262144, WS_HD = 5 * MiB;
constexpr size_t WS_WGU = 8 * MiB, WS_WD = 52 * MiB, WS_WIN = 74 * MiB, WS_WOUT = 98 * MiB, WS_WQ = 106 * MiB, WS_WKV = 108 * MiB, WS_WO = 112 * MiB;
constexpr size_t WS_XB = 114 * MiB, WS_ACT = 146 * MiB, WS_QR = 210 * MiB, WS_CA = 226 * MiB, WS_PROJ = 234 * MiB, WS_OMIX = 330 * MiB;
constexpr size_t WS_UT = 114 * MiB  , WS_ST = 178 * MiB  ;
constexpr size_t WS_KCR = 362 * MiB, WS_KSR = 364 * MiB, WS_KWR = 366 * MiB, WS_GATE = 368 * MiB, WS_QX = 370 * MiB, WS_OX = 378 * MiB, WS_KVX = 386 * MiB, WS_MEMN = 387 * MiB, WS_W1T = 389 * MiB, WS_HID = 391 * MiB, WS_END = 392 * MiB;
constexpr int CW_BAR = 4096;
constexpr int RING_OFF = 0, RING_BYTES = 131072;
constexpr int LDSCTL_OFF = RING_BYTES, MISC_OFF = LDSCTL_OFF + 320;
constexpr int LDS_BYTES = 147456;

#define DI __device__ __forceinline__
DI float bf2f(unsigned short h) { return __uint_as_float((unsigned)h << 16); }
DI float wave_sum(float v) {
#pragma unroll
    for (int o = 1; o < 64; o <<= 1) v += __shfl_xor(v, o);
    return v;
}
DI float wave_max(float v) {
#pragma unroll
    for (int o = 1; o < 64; o <<= 1) v = fmaxf(v, __shfl_xor(v, o));
    return v;
}
using pg8::silu_f;
constexpr float LOG2E = 1.4426950408889634f;
DI float sigmoid_f(float x) { return 1.0f / (1.0f + __expf(-x)); }

struct Args { const float* in[28]; float* out; unsigned char* ws; int ph_lo, ph_hi; };
typedef const __attribute__((address_space(4))) unsigned char* kaptr_t;
struct AP {
    kaptr_t ka;
    __device__ __forceinline__ const float* in_(int i) const { return *(const float* const __attribute__((address_space(4)))*)(ka + 8 * i); }
    __device__ __forceinline__ float* out_() const { return *(float* const __attribute__((address_space(4)))*)(ka + 8 * 28); }
    __device__ __forceinline__ unsigned char* ws_() const { return *(unsigned char* const __attribute__((address_space(4)))*)(ka + 8 * 29); }
};
__device__ __forceinline__ AP make_ap() { kaptr_t k = (kaptr_t)__builtin_amdgcn_kernarg_segment_ptr(); asm volatile("" : "+s"(k)); AP a; a.ka = k; return a; }

__constant__ float ROPE_INV[32] = {1.000000000e+00f, 7.498942614e-01f, 5.623413324e-01f, 4.216965139e-01f, 3.162277639e-01f, 2.371373773e-01f, 1.778279394e-01f, 1.333521307e-01f, 1.000000015e-01f, 7.498941571e-02f, 5.623413250e-02f, 4.216965288e-02f, 3.162277490e-02f, 2.371373773e-02f, 1.778279431e-02f, 1.333521493e-02f, 9.999999776e-03f, 7.498941850e-03f, 5.623413250e-03f, 4.216964822e-03f, 3.162277630e-03f, 2.371373586e-03f, 1.778279431e-03f, 1.333521446e-03f, 1.000000047e-03f, 7.498942432e-04f, 5.623413017e-04f, 4.216965172e-04f, 3.162277571e-04f, 2.371373703e-04f, 1.778279402e-04f, 1.333521504e-04f};

DI void sincos_acc(float angf, float& c, float& s) {
    const double x = (double)angf;
    const double n = __builtin_rint(x * 0.63661977236758134308);
    double r = __builtin_fma(-n, 1.57079632679489655800, x); r = __builtin_fma(-n, 6.12323399573676603587e-17, r);
    const int q = ((int)n) & 3;
    const double r2 = r * r;
    const double sp = r * (1.0 + r2 * (-1.0 / 6.0 + r2 * (1.0 / 120.0 + r2 * (-1.0 / 5040.0 + r2 * (1.0 / 362880.0 + r2 * (-1.0 / 39916800.0 + r2 * (1.0 / 6227020800.0 + r2 * (-1.0 / 1307674368000.0))))))));
    const double cp = 1.0 + r2 * (-0.5 + r2 * (1.0 / 24.0 + r2 * (-1.0 / 720.0 + r2 * (1.0 / 40320.0 + r2 * (-1.0 / 3628800.0 + r2 * (1.0 / 479001600.0 + r2 * (-1.0 / 87178291200.0 + r2 * (1.0 / 20922789888000.0))))))));
    const double sv = (q == 0) ? sp : (q == 1) ? cp : (q == 2) ? -sp : -cp;
    const double cv = (q == 0) ? cp : (q == 1) ? -sp : (q == 2) ? -cp : sp;
    c = (float)cv; s = (float)sv;
}

DI void tr_item(const float* W, int K, int N, bf16* WT, int dst_row0, const float* ks, LAS unsigned char* scr, int k0, int n0, int lane) {
    const int n4 = (lane & 15) * 4, rq = lane >> 4; const bool ok = (n0 + n4) < N;
    f32x4 v[16];
#pragma unroll
    for (int i = 0; i < 16; ++i) { const int row = 4 * i + rq; v[i] = ok ? *(const GAS f32x4*)(W + (size_t)(k0 + row) * N + n0 + n4) : (f32x4){0.f, 0.f, 0.f, 0.f}; }
#pragma unroll
    for (int i = 0; i < 16; ++i) { const int row = 4 * i + rq; f32x4 x = v[i]; if (ks) x = x * ks[k0 + row];
        *(LAS unsigned long long*)(scr + row * 136 + n4 * 2) = (unsigned long long)pk2(x.x, x.y) | ((unsigned long long)pk2(x.z, x.w) << 32); }
    LDS_WAIT(); asm volatile("" ::: "memory");
    const int c = lane & 7;
#pragma unroll
    for (int j = 0; j < 8; ++j) { const int nn = (lane >> 3) + 8 * j; const LAS unsigned char* s = scr + (8 * c) * 136 + nn * 2;
        v4u o;
        o.x = (unsigned)*(const LAS unsigned short*)(s + 0 * 136) | ((unsigned)*(const LAS unsigned short*)(s + 1 * 136) << 16);
        o.y = (unsigned)*(const LAS unsigned short*)(s + 2 * 136) | ((unsigned)*(const LAS unsigned short*)(s + 3 * 136) << 16);
        o.z = (unsigned)*(const LAS unsigned short*)(s + 4 * 136) | ((unsigned)*(const LAS unsigned short*)(s + 5 * 136) << 16);
        o.w = (unsigned)*(const LAS unsigned short*)(s + 6 * 136) | ((unsigned)*(const LAS unsigned short*)(s + 7 * 136) << 16);
        *(GAS v4u*)(WT + (size_t)(dst_row0 + nn) * K + k0 + 8 * c) = o; }
    LDS_WAIT(); asm volatile("" ::: "memory");
}
DI bool tr_job(int& r, const float* W, int K, int N, bf16* WT, int mode, int row_off, const float* ks, LAS unsigned char* scr, int lane) {
    const int nblk = (N + 63) / 64, nitems = (K / 64) * nblk;
    if (r >= nitems) { r -= nitems; return false; }
    const int kb = r / nblk, nb = r % nblk, n0 = 64 * nb;
    const int dst = (mode == 0) ? row_off + n0 : ((n0 >> 7) * 256 + (n0 & 127) + (mode == 2 ? 128 : 0));
    tr_item(W, K, N, WT, dst, ks, scr, 64 * kb, n0, lane);
    return true;
}
DI void row_to_bf16(const float* xrow, bf16* orow, float* ssq_row, const float* w, int lane) {
    const GAS f32x4* xr = (const GAS f32x4*)xrow + lane;
    f32x4 v[8]; float s = 0.f;
#pragma unroll
    for (int j = 0; j < 8; ++j) { v[j] = xr[64 * j]; s += (v[j].x * v[j].x + v[j].y * v[j].y) + (v[j].z * v[j].z + v[j].w * v[j].w); }
    s = wave_sum(s);
    float rs = 1.f;
    if (w) rs = __builtin_amdgcn_rsqf(s * (1.0f / 2048.0f) + 1e-6f);
    GAS unsigned long long* o8 = (GAS unsigned long long*)orow + lane;
#pragma unroll
    for (int j = 0; j < 8; ++j) { f32x4 t = v[j] * rs; if (w) { const f32x4 wv = ((const GAS f32x4*)w)[lane + 64 * j]; t = t * wv; }
        o8[64 * j] = (unsigned long long)pk2(t.x, t.y) | ((unsigned long long)pk2(t.z, t.w) << 32); }
    if (ssq_row && lane < 32) ssq_row[lane] = (lane == 0) ? s : 0.f;
}

DI void phase_prologue(const AP a, LAS unsigned char* lds, int gw, int NGW, int wave, int lane) {
    unsigned char* ws = a.ws_();
    LAS unsigned char* scr = lds + RING_OFF + wave * 16384;
    constexpr int I_GU = 32 * 88, I_D = 88 * 32, I_IN = 32 * 93, I_OUT = 32 * 32, I_Q = 32 * 8, I_O = 8 * 32;
    constexpr int I_C = 32 * 4;
    constexpr int NITEMS = 2 * I_GU + I_D + I_IN + I_OUT + 3 * I_Q + I_O + 2 * I_C;
    for (int it = gw; it < NITEMS; it += NGW) {
        int r = it;
        if (tr_job(r, a.in_(4), DM, FF, (bf16*)(ws + WS_WGU), 1, 0, a.in_(3), scr, lane)) continue;
        if (tr_job(r, a.in_(5), DM, FF, (bf16*)(ws + WS_WGU), 2, 0, a.in_(3), scr, lane)) continue;
        if (tr_job(r, a.in_(6), FF, DM, (bf16*)(ws + WS_WD), 0, 0, nullptr, scr, lane)) continue;
        if (tr_job(r, a.in_(8), DM, DIN, (bf16*)(ws + WS_WIN), 0, 0, a.in_(7), scr, lane)) continue;
        if (tr_job(r, a.in_(16), DM, DM, (bf16*)(ws + WS_WOUT), 0, 0, nullptr, scr, lane)) continue;
        if (tr_job(r, a.in_(19), DM, 512, (bf16*)(ws + WS_WQ), 0, 0, a.in_(17), scr, lane)) continue;
        if (tr_job(r, a.in_(20), DM, 512, (bf16*)(ws + WS_WKV), 0, 0, nullptr, scr, lane)) continue;
        if (tr_job(r, a.in_(21), DM, 512, (bf16*)(ws + WS_WKV), 0, 512, nullptr, scr, lane)) continue;
        if (tr_job(r, a.in_(22), 512, DM, (bf16*)(ws + WS_WO), 0, 0, nullptr, scr, lane)) continue;
        if (tr_job(r, a.in_(12), 2048, 256, (bf16*)(ws + WS_W1T), 0, 0, nullptr, scr, lane)) continue;
        tr_job(r, a.in_(14), 2048, 256, (bf16*)(ws + WS_W1T), 0, 256, nullptr, scr, lane);
    }
    for (int m = gw; m < NTOK; m += NGW) row_to_bf16(a.in_(0) + (size_t)m * DM, (bf16*)(ws + WS_XB) + (size_t)m * DM, (float*)(ws + WS_SSQ) + (size_t)m * 32, nullptr, lane);
    for (int m = gw; m < 512; m += NGW) row_to_bf16(a.in_(1) + (size_t)m * DM, (bf16*)(ws + WS_MEMN) + (size_t)m * DM, nullptr, a.in_(18), lane);
    {
        const int* pos = (const int*)a.in_(2); float* ct = (float*)(ws + WS_COS); float* st = (float*)(ws + WS_SIN);
        for (int it = gw; it < NTOK / 2; it += NGW) { const int tok = 2 * it + (lane >> 5), i = lane & 31;
            const float ang = (float)pos[tok] * ROPE_INV[i]; float c, s; sincos_acc(ang, c, s); ct[tok * 32 + i] = c; st[tok * 32 + i] = s; }
    }
    {
        const float* lg = a.in_(9); float* lb = (float*)(ws + WS_LB);
        for (int it = gw; it < 16; it += NGW) { const int i = it * 64 + lane; lb[i] = 1.0f / (1.0f + expf(lg[1024 + i] - lg[i])); }
    }
}
DI void phase_ffn2_weights(const AP a, LAS unsigned char* lds, int gw, int NGW, int wave, int lane) {
    unsigned char* ws = a.ws_();
    LAS unsigned char* scr = lds + RING_OFF + wave * 16384;
    constexpr int I_GU = 32 * 88, I_D = 88 * 32, NITEMS = 2 * I_GU + I_D;
    for (int it = gw; it < NITEMS; it += NGW) {
        int r = it;
        if (tr_job(r, a.in_(24), DM, FF, (bf16*)(ws + WS_WGU), 1, 0, a.in_(23), scr, lane)) continue;
        if (tr_job(r, a.in_(25), DM, FF, (bf16*)(ws + WS_WGU), 2, 0, a.in_(23), scr, lane)) continue;
        tr_job(r, a.in_(26), FF, DM, (bf16*)(ws + WS_WD), 0, 0, nullptr, scr, lane);
    }
}

DI void phase_postproj(const AP a, int gw, int NGW, int lane) {
    unsigned char* ws = a.ws_();
    const bf16* proj = (const bf16*)(ws + WS_PROJ); const float* ct = (const float*)(ws + WS_COS); const float* st = (const float*)(ws + WS_SIN);
    const float* pe = a.in_(11);
    bf16* qr = (bf16*)(ws + WS_QR); bf16* ksr = (bf16*)(ws + WS_KSR); bf16* kwr = (bf16*)(ws + WS_KWR); float* gate = (float*)(ws + WS_GATE);
    for (int tok = gw; tok < NTOK; tok += NGW) {
        const bf16* pr = proj + (size_t)tok * DINP;
#pragma unroll
        for (int j = 0; j < 8; ++j) { const int p = lane + 64 * j, head = p >> 5, i = p & 31; const float c = ct[tok * 32 + i], s = st[tok * 32 + i];
            const float x1 = bf2f(pr[C_NQ + head * 64 + i]), x2 = bf2f(pr[C_NQ + head * 64 + i + 32]);
            qr[(size_t)tok * 1024 + head * 64 + i] = (bf16)f2bf((x1 * c - x2 * s) * (0.125f * LOG2E)); qr[(size_t)tok * 1024 + head * 64 + i + 32] = (bf16)f2bf((x2 * c + x1 * s) * (0.125f * LOG2E)); }
        const int g = lane >> 5, i = lane & 31; const float c = ct[tok * 32 + i], sn = st[tok * 32 + i];
#pragma unroll
        for (int j = 0; j < 2; ++j) { const int src = (j == 0) ? C_KS : C_KW; bf16* dst = (j == 0) ? ksr : kwr;
            const float x1 = bf2f(pr[src + g * 64 + i]), x2 = bf2f(pr[src + g * 64 + i + 32]);
            dst[(size_t)tok * 128 + g * 64 + i] = (bf16)f2bf(x1 * c - x2 * sn); dst[(size_t)tok * 128 + g * 64 + i + 32] = (bf16)f2bf(x2 * c + x1 * sn); }
        {
            const int b = tok >> 12, t = tok & 4095, jj = t >> 4, tin = t & 15; const size_t rowbase = (size_t)((b * 2 + g) * 256);
            const float k1 = bf2f(pr[C_KC + g * 64 + i]), k2 = bf2f(pr[C_KC + g * 64 + i + 32]);
            const float kr1 = k1 * c - k2 * sn, kr2 = k2 * c + k1 * sn, v1 = bf2f(pr[C_VC + g * 64 + i]), v2 = bf2f(pr[C_VC + g * 64 + i + 32]);
            bf16* cak = (bf16*)(ws + WS_CA); bf16* cav = cak + (size_t)1024 * 2048;
            if (jj <= 254) { const int pp = tin * 64 + i; const size_t o = (rowbase + jj) * 2048 + pp;
                cak[o] = (bf16)f2bf(kr1 + pe[pp]); cak[o + 32] = (bf16)f2bf(kr2 + pe[pp + 32]); cav[o] = (bf16)f2bf(v1 + pe[pp]); cav[o + 32] = (bf16)f2bf(v2 + pe[pp + 32]); }
            if (jj >= 1) { const int pp = (16 + tin) * 64 + i; const size_t o = (rowbase + jj - 1) * 2048 + pp;
                cak[o] = (bf16)f2bf(kr1 + pe[pp]); cak[o + 32] = (bf16)f2bf(kr2 + pe[pp + 32]); cav[o] = (bf16)f2bf(v1 + pe[pp]); cav[o + 32] = (bf16)f2bf(v2 + pe[pp + 32]); }
        }
        if (lane < 48) gate[tok * 48 + lane] = sigmoid_f(bf2f(pr[C_GATE + lane]));
    }
    for (int it = gw; it < 8; it += NGW) {
        bf16* row = (bf16*)(ws + WS_CA) + ((size_t)(it >> 2) * 1024 + (it & 3) * 256 + 255) * 2048;
#pragma unroll
        for (int j = 0; j < 4; ++j) ((GAS v4u*)row)[lane + 64 * j] = (v4u){0u, 0u, 0u, 0u};
    }
}

constexpr int HG_LF = 0, HG_SEGT = 32768, HG_QT = 34816, HG_KT = 52224, HG_QB = 69632, HG_VT = 87040, HG_ATT = 105472, HG_RS = 114688, HG_LB = 115200, HG_END = 115712;
constexpr int P128 = 272, P64 = 144;
DI bf16x8 lds_frag(const LAS unsigned char* p) { return *(const LAS bf16x8*)p; }
#define MFMA16(a, b, c) __builtin_amdgcn_mfma_f32_16x16x32_bf16((a), (b), (c), 0, 0, 0)

DI void hg_load_chunk(const bf16* proj, const float* lbg, LAS unsigned char* lds, int tok0, int h, int tid) {
    LAS float* LF = (LAS float*)(lds + HG_LF); LAS float* LB = (LAS float*)(lds + HG_LB);
    if (tid < 128) LB[tid] = lbg[h * 128 + tid];
    __syncthreads();
#pragma unroll
    for (int j = 0; j < 2; ++j) { const int idx = tid + 512 * j, t = idx >> 4, c8 = idx & 15;
        const bf16* pr = proj + (size_t)(tok0 + t) * DINP + h * 128 + 8 * c8;
        const v4u wf = *(const GAS v4u*)(pr + C_HF), wv = *(const GAS v4u*)(pr + C_HI);
        const unsigned fw[4] = {wf.x, wf.y, wf.z, wf.w}, vw[4] = {wv.x, wv.y, wv.z, wv.w};
#pragma unroll
        for (int e = 0; e < 8; ++e) { const int k = 8 * c8 + e; const float fl = __uint_as_float((e & 1) ? (fw[e >> 1] & 0xffff0000u) : (fw[e >> 1] << 16));
            const float lb = LB[k], f = lb + (1.f - lb) * sigmoid_f(fl);
            LF[t * 128 + k] = __logf(f);
            *(LAS unsigned short*)(lds + HG_VT + k * P64 + 2 * t) = (unsigned short)((e & 1) ? (vw[e >> 1] >> 16) : (vw[e >> 1] & 0xffffu)); }
    }
    __syncthreads();
}
DI void hg_scan_local(LAS unsigned char* lds, int tid) {
    LAS float* LF = (LAS float*)(lds + HG_LF); LAS float* SEGT = (LAS float*)(lds + HG_SEGT);
    const int k = tid & 127, seg = tid >> 7; float s = 0.f;
#pragma unroll
    for (int j = 0; j < 16; ++j) { s += LF[(16 * seg + j) * 128 + k]; LF[(16 * seg + j) * 128 + k] = s; }
    SEGT[seg * 128 + k] = s;
    __syncthreads();
}
DI float exp_c(float x) { return __expf(fminf(x, 80.f)); }

DI void hgrn_a_unit(const AP a, LAS unsigned char* lds, int unit, int tid, int wave, int lane) {
    unsigned char* ws = a.ws_();
    const int bh = unit >> 6, c = unit & 63, b = bh >> 3, h = bh & 7, tok0 = b * SEQ + c * 64;
    hg_load_chunk((const bf16*)(ws + WS_PROJ), (const float*)(ws + WS_LB), lds, tok0, h, tid);
    hg_scan_local(lds, tid);
    {
        LAS float* LF = (LAS float*)(lds + HG_LF); LAS float* SEGT = (LAS float*)(lds + HG_SEGT);
        const int k = tid & 127, seg = tid >> 7;
        const float s0 = SEGT[k], s1 = SEGT[128 + k], s2 = SEGT[256 + k], s3 = SEGT[384 + k];
        const float off = (seg == 0) ? 0.f : (seg == 1) ? s0 : (seg == 2) ? (s0 + s1) : ((s0 + s1) + s2), blast = ((s0 + s1) + s2) + s3;
        float prev = off;
#pragma unroll
        for (int j = 0; j < 16; ++j) { const int t = 16 * seg + j; const float bt = LF[t * 128 + k] + off, f = __expf(bt - prev); prev = bt;
            *(LAS unsigned short*)(lds + HG_QT + k * P64 + 2 * t) = (unsigned short)f2bf((1.f - f) * exp_c(blast - bt)); }
        if (seg == 0) ((float*)(ws + WS_HD))[(size_t)unit * 128 + k] = __expf(blast);
    }
    __syncthreads();
    {
        const int r = lane & 15, q = lane >> 4;
        f32x4 acc[8];
#pragma unroll
        for (int n = 0; n < 8; ++n) acc[n] = (f32x4){0.f, 0.f, 0.f, 0.f};
#pragma unroll
        for (int ks = 0; ks < 2; ++ks) { const bf16x8 av = lds_frag(lds + HG_QT + (16 * wave + r) * P64 + (32 * ks + 8 * q) * 2);
#pragma unroll
            for (int n = 0; n < 8; ++n) acc[n] = MFMA16(av, lds_frag(lds + HG_VT + (16 * n + r) * P64 + (32 * ks + 8 * q) * 2), acc[n]); }
        float* ut = (float*)(ws + WS_UT) + (size_t)unit * 16384;
#pragma unroll
        for (int n = 0; n < 8; ++n) *(f32x4*)(ut + (16 * n + r) * 128 + 16 * wave + 4 * q) = acc[n];
    }
    __syncthreads();
}
DI void hgrn_b_scan(const AP a, int e0, int estride) {
    unsigned char* ws = a.ws_();
    const float* ut = (const float*)(ws + WS_UT); const float* hd = (const float*)(ws + WS_HD); bf16* st = (bf16*)(ws + WS_ST);
    for (int e = e0; e < 16 * 16384; e += estride) { const int bh = e >> 14, vk = e & 16383, k = vk & 127; float s = 0.f;
        const size_t base = (size_t)bh * 64 * 16384 + vk;
#pragma unroll 8
        for (int c = 0; c < 64; ++c) { st[base + (size_t)c * 16384] = (bf16)f2bf(s); s = hd[(bh * 64 + c) * 128 + k] * s + ut[base + (size_t)c * 16384]; }
    }
}
DI void hgrn_c_unit(const AP a, LAS unsigned char* lds, int unit, int tid, int wave, int lane) {
    unsigned char* ws = a.ws_();
    const int bh = unit >> 6, c = unit & 63, b = bh >> 3, h = bh & 7, tok0 = b * SEQ + c * 64;
    const bf16* proj = (const bf16*)(ws + WS_PROJ);
    hg_load_chunk(proj, (const float*)(ws + WS_LB), lds, tok0, h, tid);
    hg_scan_local(lds, tid);
    {
        LAS float* LF = (LAS float*)(lds + HG_LF); LAS float* SEGT = (LAS float*)(lds + HG_SEGT);
        const int k = tid & 127, seg = tid >> 7;
        const float s0 = SEGT[k], s1 = SEGT[128 + k], s2 = SEGT[256 + k];
        const float off = (seg == 0) ? 0.f : (seg == 1) ? s0 : (seg == 2) ? (s0 + s1) : ((s0 + s1) + s2), rr = s0 + s1;
        float prev = off;
#pragma unroll
        for (int j = 0; j < 16; ++j) { const int t = 16 * seg + j; const float bt = LF[t * 128 + k] + off, f = __expf(bt - prev); prev = bt;
            const float qv = bf2f(proj[(size_t)(tok0 + t) * DINP + C_HQ + h * 128 + k]);
            *(LAS unsigned short*)(lds + HG_QT + t * P128 + 2 * k) = (unsigned short)f2bf(qv * exp_c(bt - rr));
            *(LAS unsigned short*)(lds + HG_KT + t * P128 + 2 * k) = (unsigned short)f2bf((1.f - f) * exp_c(rr - bt));
            *(LAS unsigned short*)(lds + HG_QB + t * P128 + 2 * k) = (unsigned short)f2bf(qv * __expf(bt)); }
    }
    __syncthreads();
    const int r = lane & 15, q = lane >> 4, tt = wave >> 1, wh = wave & 1;
    {
#pragma unroll
        for (int si = 0; si < 2; ++si) { const int stile = 2 * wh + si; f32x4 acc = (f32x4){0.f, 0.f, 0.f, 0.f};
            if (stile <= tt) {
#pragma unroll
                for (int ks = 0; ks < 4; ++ks) acc = MFMA16(lds_frag(lds + HG_QT + (16 * tt + r) * P128 + (32 * ks + 8 * q) * 2), lds_frag(lds + HG_KT + (16 * stile + r) * P128 + (32 * ks + 8 * q) * 2), acc);
            }
#pragma unroll
            for (int e = 0; e < 4; ++e) { const int t = 16 * tt + 4 * q + e, s = 16 * stile + r; const float v = (stile <= tt && s <= t) ? acc[e] : 0.f;
                *(LAS unsigned short*)(lds + HG_ATT + t * P64 + 2 * s) = (unsigned short)f2bf(v); }
        }
    }
    __syncthreads();
    {
        f32x4 acc[4];
#pragma unroll
        for (int n = 0; n < 4; ++n) acc[n] = (f32x4){0.f, 0.f, 0.f, 0.f};
#pragma unroll
        for (int ks = 0; ks < 2; ++ks) { const bf16x8 av = lds_frag(lds + HG_ATT + (16 * tt + r) * P64 + (32 * ks + 8 * q) * 2);
#pragma unroll
            for (int n = 0; n < 4; ++n) acc[n] = MFMA16(av, lds_frag(lds + HG_VT + (16 * (4 * wh + n) + r) * P64 + (32 * ks + 8 * q) * 2), acc[n]); }
        const bf16* st = (const bf16*)(ws + WS_ST) + (size_t)unit * 16384;
#pragma unroll
        for (int ks = 0; ks < 4; ++ks) { const bf16x8 av = lds_frag(lds + HG_QB + (16 * tt + r) * P128 + (32 * ks + 8 * q) * 2);
#pragma unroll
            for (int n = 0; n < 4; ++n) { const bf16x8 bv = *(const GAS bf16x8*)(st + (16 * (4 * wh + n) + r) * 128 + 32 * ks + 8 * q); acc[n] = MFMA16(av, bv, acc[n]); } }
        LAS float* RS = (LAS float*)(lds + HG_RS);
        float p[4];
#pragma unroll
        for (int e = 0; e < 4; ++e) { p[e] = (acc[0][e] * acc[0][e] + acc[1][e] * acc[1][e]) + (acc[2][e] * acc[2][e] + acc[3][e] * acc[3][e]);
            p[e] += __shfl_xor(p[e], 1); p[e] += __shfl_xor(p[e], 2); p[e] += __shfl_xor(p[e], 4); p[e] += __shfl_xor(p[e], 8);
            if (r == 0) RS[(16 * tt + 4 * q + e) * 2 + wh] = p[e]; }
        __syncthreads();
        const float* nw = a.in_(10); bf16* omix = (bf16*)(ws + WS_OMIX);
#pragma unroll
        for (int e = 0; e < 4; ++e) { const int t = 16 * tt + 4 * q + e; const float rs = __builtin_amdgcn_rsqf((RS[t * 2] + RS[t * 2 + 1]) * (1.0f / 128.0f) + 1e-6f);
#pragma unroll
            for (int n = 0; n < 4; ++n) { const int v = 16 * (4 * wh + n) + r; const float g = bf2f(proj[(size_t)(tok0 + t) * DINP + C_HG + h * 128 + v]);
                omix[(size_t)(tok0 + t) * DM + h * 128 + v] = (bf16)f2bf(acc[n][e] * rs * nw[h * 128 + v] * silu_f(g)); } }
    }
    __syncthreads();
}
DI void phase_cmp_out(const AP a, int gw, int NGW, int lane) {
    unsigned char* ws = a.ws_();
    for (int it = gw; it < 2 * 1024; it += NGW) {
        const int kv = it >> 10, row = it & 1023; const bf16* hid = (const bf16*)(ws + WS_HID) + (size_t)kv * 262144 + (size_t)row * 256; const float* w2 = a.in_(kv ? 15 : 13);
        float acc = 0.f;
#pragma unroll 8
        for (int j = 0; j < 256; ++j) acc += bf2f(hid[j]) * w2[j * 64 + lane];
        ((bf16*)(ws + (kv ? WS_VC : WS_KC)))[row * 64 + lane] = (bf16)f2bf(acc);
    }
}
typedef float f32x16 __attribute__((ext_vector_type(16)));
typedef float f32x2_t __attribute__((ext_vector_type(2))); typedef __bf16 bf16x2_t __attribute__((ext_vector_type(2)));
typedef unsigned u32x2_t __attribute__((ext_vector_type(2))); typedef unsigned u32x4_t __attribute__((ext_vector_type(4)));
#define MFMA32(a, b, c) __builtin_amdgcn_mfma_f32_32x32x16_bf16((a), (b), (c), 0, 0, 0)
DI unsigned cvtpk_s(float lo, float hi) { f32x2_t v = {lo, hi}; bf16x2_t b = __builtin_convertvector(v, bf16x2_t); return __builtin_bit_cast(unsigned, b); }
DI int crow(int reg, int h) { return (reg & 3) + 8 * (reg >> 2) + 4 * h; }
constexpr int AT_KT0 = 0, AT_KT1 = 9216, AT_VT0 = 18432, AT_VT1 = 30720, AT_IMP = 43008, AT_MASKS = 51200, AT_LIST = 51456, AT_OACC = 51712  ;
struct Stg64 { v4u k, v; };
DI Stg64 stg_load64(const bf16* kbase, size_t kpitch, const bf16* vbase, size_t vpitch, int tid) {
    const int key = tid >> 3, ch = tid & 7; Stg64 s; s.k = *(const GAS v4u*)(kbase + (size_t)key * kpitch + ch * 8); s.v = *(const GAS v4u*)(vbase + (size_t)key * vpitch + ch * 8); return s;
}
DI void stg_write64(LAS unsigned char* kt, LAS unsigned char* vt, const Stg64& s, int tid) {
    const int key = tid >> 3, ch = tid & 7;
    *(LAS v4u*)(kt + key * 144 + ch * 16) = s.k;
    *(LAS v4u*)(vt + key * 192 + ch * 16) = s.v;
}
DI void qk_tile64(f32x16 (&p)[2], const LAS unsigned char* kt, const bf16x8 (&qf)[4], int r, int h) {
#pragma unroll
    for (int kb = 0; kb < 2; ++kb) { f32x16 acc;
#pragma unroll
        for (int i = 0; i < 16; ++i) acc[i] = 0.f;
#pragma unroll
        for (int ks = 0; ks < 4; ++ks) acc = MFMA32(*(const LAS bf16x8*)(kt + (kb * 32 + r) * 144 + (16 * ks + 8 * h) * 2), qf[ks], acc);
        p[kb] = acc; }
}
typedef short v4i16_t __attribute__((ext_vector_type(4)));
DI v4i16_t vtr(const LAS unsigned char* p) { return __builtin_amdgcn_ds_read_tr16_b64_v4i16((LAS v4i16_t*)p); }
DI void pv_tile64(f32x16 (&od)[2], const LAS unsigned char* vt, const f32x16 (&p)[2], int lane) {
    const LAS unsigned char* vb = vt + (4 * (lane >> 5) + ((lane & 15) >> 2)) * 192 + (16 * ((lane >> 4) & 1) + 4 * (lane & 3)) * 2;
#pragma unroll
    for (int kb = 0; kb < 2; ++kb)
#pragma unroll
        for (int s = 0; s < 2; ++s) {
            u32x4_t pw; pw[0] = cvtpk_s(p[kb][8 * s + 0], p[kb][8 * s + 1]); pw[1] = cvtpk_s(p[kb][8 * s + 2], p[kb][8 * s + 3]); pw[2] = cvtpk_s(p[kb][8 * s + 4], p[kb][8 * s + 5]); pw[3] = cvtpk_s(p[kb][8 * s + 6], p[kb][8 * s + 7]);
            const bf16x8 pf = __builtin_bit_cast(bf16x8, pw);
#pragma unroll
            for (int db = 0; db < 2; ++db) { const LAS unsigned char* vp = vb + (kb * 32 + 16 * s) * 192 + db * 64;
                const v4i16_t lo = vtr(vp), hi = vtr(vp + 8 * 192);
                od[db] = MFMA32(__builtin_shufflevector(lo, hi, 0, 1, 2, 3, 4, 5, 6, 7), pf, od[db]); } }
}
DI void softmax_online(f32x16 (&p)[2], float& m, float& l, f32x16 (&od)[2]) {
    float mt = -INFINITY;
#pragma unroll
    for (int kb = 0; kb < 2; ++kb)
#pragma unroll
        for (int i = 0; i < 16; ++i) mt = fmaxf(mt, p[kb][i]);
    mt = fmaxf(mt, __shfl_xor(mt, 32));
    const float mn = fmaxf(m, mt), ms = (mn == -INFINITY) ? 0.f : mn, alpha = __builtin_amdgcn_exp2f(m - ms);
    const bool grew = !__all(mt <= m);
    m = mn;
    float ls = 0.f;
#pragma unroll
    for (int kb = 0; kb < 2; ++kb)
#pragma unroll
        for (int i = 0; i < 16; ++i) { const float e = __builtin_amdgcn_exp2f(p[kb][i] - ms); p[kb][i] = e; ls += e; }
    l = l * alpha + ls;
    if (grew) {
#pragma unroll
        for (int db = 0; db < 2; ++db)
#pragma unroll
            for (int i = 0; i < 16; ++i) od[db][i] *= alpha;
    }
}
DI void qk_tile64_init(f32x16 (&p)[2], const LAS unsigned char* kt, const bf16x8 (&qf)[4], int r, int h, float cinit) {
#pragma unroll
    for (int kb = 0; kb < 2; ++kb) { f32x16 acc;
#pragma unroll
        for (int i = 0; i < 16; ++i) acc[i] = cinit;
#pragma unroll
        for (int ks = 0; ks < 4; ++ks) acc = MFMA32(*(const LAS bf16x8*)(kt + (kb * 32 + r) * 144 + (16 * ks + 8 * h) * 2), qf[ks], acc);
        p[kb] = acc; }
}
DI float max3f(float a, float b, float c) { return fmaxf(fmaxf(a, b), c); }
DI void softmax_deferred(f32x16 (&p)[2], float& m, float& l, f32x16 (&od)[2]) {
    float ma = max3f(p[0][0], p[0][1], p[1][0]), mb = max3f(p[0][2], p[0][3], p[1][1]); ma = max3f(ma, p[1][2], p[1][3]);
#pragma unroll
    for (int i = 4; i < 16; i += 4) { ma = max3f(ma, p[0][i], p[0][i + 1]); mb = max3f(mb, p[0][i + 2], p[0][i + 3]); ma = max3f(ma, p[1][i], p[1][i + 1]); mb = max3f(mb, p[1][i + 2], p[1][i + 3]); }
    float mt = fmaxf(ma, mb); mt = fmaxf(mt, __shfl_xor(mt, 32));
    if (__any(mt > 8.0f)) {
        const float delta = fmaxf(mt, 0.f), alpha = __builtin_amdgcn_exp2f(-delta);
        m += delta; l *= alpha;
#pragma unroll
        for (int kb = 0; kb < 2; ++kb)
#pragma unroll
            for (int i = 0; i < 16; ++i) p[kb][i] -= delta;
#pragma unroll
        for (int db = 0; db < 2; ++db)
#pragma unroll
            for (int i = 0; i < 16; ++i) od[db][i] *= alpha;
    }
    float ls = 0.f, ls1 = 0.f;
#pragma unroll
    for (int kb = 0; kb < 2; ++kb)
#pragma unroll
        for (int i = 0; i < 16; i += 2) { const float e0 = __builtin_amdgcn_exp2f(p[kb][i]), e1 = __builtin_amdgcn_exp2f(p[kb][i + 1]); p[kb][i] = e0; p[kb][i + 1] = e1; ls += e0; ls1 += e1; }
    l += ls + ls1;
}
#define TILE_STREAM(NT, KSRC, KPITCH, VSRC, VPITCH, ...) do { const int nt_ = (NT); if (nt_ > 0) { \
    Stg64 sg_; { const int i = 0; (void)i; sg_ = stg_load64(KSRC, KPITCH, VSRC, VPITCH, tid); } \
    stg_write64(lds + AT_KT0, lds + AT_VT0, sg_, tid); __syncthreads(); \
    for (int i_ = 0; i_ < nt_; ++i_) { const int cur_ = i_ & 1; \
        if (i_ + 1 < nt_) { const int i = i_ + 1; (void)i; sg_ = stg_load64(KSRC, KPITCH, VSRC, VPITCH, tid); } \
        { const int i = i_; (void)i; const LAS unsigned char* kt = lds + (cur_ ? AT_KT1 : AT_KT0); const LAS unsigned char* vt = lds + (cur_ ? AT_VT1 : AT_VT0); (void)vt; __VA_ARGS__ } \
        if (i_ + 1 < nt_) stg_write64(lds + (cur_ ? AT_KT0 : AT_KT1), lds + (cur_ ? AT_VT0 : AT_VT1), sg_, tid); \
        __syncthreads(); } } } while (0)

DI void cmp_stats_tile(f32x16 (&p)[2], const LAS unsigned char* kt, const bf16x8 (&qf)[4], int r, int h, int i, int nrow, float& m, float& l) {
    qk_tile64(p, kt, qf, r, h);
    float mt = -INFINITY;
#pragma unroll
    for (int kb = 0; kb < 2; ++kb)
#pragma unroll
        for (int e = 0; e < 16; ++e) { const int n = 64 * i + 32 * kb + crow(e, h); const float s = (n < nrow) ? p[kb][e] : -INFINITY; p[kb][e] = s; mt = fmaxf(mt, s); }
    mt = fmaxf(mt, __shfl_xor(mt, 32));
    const float mn = fmaxf(m, mt), ms = (mn == -INFINITY) ? 0.f : mn; float ls = 0.f;
#pragma unroll
    for (int kb = 0; kb < 2; ++kb)
#pragma unroll
        for (int e = 0; e < 16; ++e) ls += __builtin_amdgcn_exp2f(p[kb][e] - ms);
    l = l * __builtin_amdgcn_exp2f(m - ms) + ls; m = mn;
}
DI void cmp_final_tile(f32x16 (&p)[2], f32x16 (&od)[2], const LAS unsigned char* kt, const LAS unsigned char* vt, const bf16x8 (&qf)[4], int r, int h, int i, int nrow, float ms, float invl, LAS float* IMP, int tl, int hh, int lane) {
    qk_tile64(p, kt, qf, r, h);
#pragma unroll
    for (int kb = 0; kb < 2; ++kb)
#pragma unroll
        for (int e = 0; e < 16; ++e) { const int n = 64 * i + 32 * kb + crow(e, h); p[kb][e] = (n < nrow) ? __builtin_amdgcn_exp2f(p[kb][e] - ms) * invl : 0.f; }
#pragma unroll
    for (int kb = 0; kb < 2; ++kb)
#pragma unroll
        for (int gq = 0; gq < 4; ++gq) { float av = (p[kb][4 * gq] + p[kb][4 * gq + 1]) + (p[kb][4 * gq + 2] + 0.5f * p[kb][4 * gq + 3]), cv = 0.5f * p[kb][4 * gq + 3];
            av += __shfl_xor(av, 1); cv += __shfl_xor(cv, 1); av += __shfl_xor(av, 2); cv += __shfl_xor(cv, 2); av += __shfl_xor(av, 4); cv += __shfl_xor(cv, 4);
            if (hh == 0) { const int j = 16 * i + 8 * kb + 2 * gq + h;
                __hip_atomic_fetch_add(IMP + tl * 64 + j, av, __ATOMIC_RELAXED, __HIP_MEMORY_SCOPE_WORKGROUP);
                if (j < 63) __hip_atomic_fetch_add(IMP + tl * 64 + j + 1, cv, __ATOMIC_RELAXED, __HIP_MEMORY_SCOPE_WORKGROUP); } }
    pv_tile64(od, vt, p, lane);
}
DI void sel_tile(f32x16 (&p)[2], f32x16 (&od)[2], const LAS unsigned char* kt, const LAS unsigned char* vt, const bf16x8 (&qf)[4], int r, int h, int lane, int j, bool sel, int t, int tmin, float& m, float& l) {
    if (!__any(sel)) return;
    qk_tile64_init(p, kt, qf, r, h, sel ? -m : -INFINITY);
    if (64 * j + 63 > tmin) {
#pragma unroll
        for (int kb = 0; kb < 2; ++kb)
#pragma unroll
            for (int e = 0; e < 16; ++e) { const int key = 64 * j + 32 * kb + crow(e, h); p[kb][e] = (key <= t) ? p[kb][e] : -INFINITY; }
    }
    softmax_deferred(p, m, l, od);
    pv_tile64(od, vt, p, lane);
}
DI void win_tile(f32x16 (&p)[2], f32x16 (&od)[2], const LAS unsigned char* kt, const LAS unsigned char* vt, const bf16x8 (&qf)[4], int r, int h, int lane, int key0, int t, int tmin, int tmax, float& m, float& l) {
    qk_tile64_init(p, kt, qf, r, h, -m);
    if (!(key0 + 63 <= tmin && key0 + 511 >= tmax)) {
#pragma unroll
        for (int kb = 0; kb < 2; ++kb)
#pragma unroll
            for (int e = 0; e < 16; ++e) { const int key = key0 + 32 * kb + crow(e, h); p[kb][e] = (key <= t && key + 511 >= t) ? p[kb][e] : -INFINITY; }
    }
    softmax_deferred(p, m, l, od);
    pv_tile64(od, vt, p, lane);
}

#ifndef XSEL
#define XSEL 0
#endif
#ifndef XWIN
#define XWIN 0
#endif
#ifndef XTOPK
#define XTOPK 0
#endif
DI void nsa_unit(const AP a, LAS unsigned char* lds, int unit, int tid, int wave, int lane) {
    unsigned char* ws = a.ws_();
    const int bg = unit >> 7, ub = unit & 127, b = bg >> 1, g = bg & 1, t0 = ub * 32, tok0 = b * SEQ + t0;
    const int r = lane & 31, h = lane >> 5, tl = 4 * wave + (r >> 3), hh = r & 7, head = g * 8 + hh, t = t0 + tl, tok = tok0 + tl;
    const bf16* proj = (const bf16*)(ws + WS_PROJ);
    bf16x8 qf[4];
    { const bf16* qp = (const bf16*)(ws + WS_QR) + (size_t)tok * 1024 + head * 64 + 8 * h;
#pragma unroll
      for (int ks = 0; ks < 4; ++ks) qf[ks] = *(const GAS bf16x8*)(qp + 16 * ks); }
    LAS float* IMP = (LAS float*)(lds + AT_IMP); volatile LAS unsigned* MASKS = (volatile LAS unsigned*)(lds + AT_MASKS); volatile LAS int* LIST = (volatile LAS int*)(lds + AT_LIST);
    for (int i = tid; i < 2048; i += NWAVES * 64) IMP[i] = 0.f;
    const int tmin = t0 + 4 * wave, tmax = tmin + 3;
    const float* gate = (const float*)(ws + WS_GATE) + (size_t)tok * 48 + head * 3;
    f32x16 od[2]; f32x16 p[2];
    LAS float* OACC = (LAS float*)(lds + AT_OACC) + wave * 2048 + lane;
    {
        const int tmax = t0 + 31; int nv = (tmax >= 31) ? ((tmax - 31) / 16 + 1) : 0; if (nv > 255) nv = 255;
        const int ntc = (nv + 63) >> 6;
        int nrow = (t >= 31) ? ((t - 31) / 16 + 1) : 0; if (nrow > 255) nrow = 255;
        const bf16* kcb = (const bf16*)(ws + WS_KC) + (size_t)bg * 256 * 64; const bf16* vcb = (const bf16*)(ws + WS_VC) + (size_t)bg * 256 * 64;
        float m = -INFINITY, l = 0.f;
#pragma unroll
        for (int db = 0; db < 2; ++db)
#pragma unroll
            for (int i = 0; i < 16; ++i) od[db][i] = 0.f;
        TILE_STREAM(ntc, kcb + (size_t)i * 64 * 64, 64, vcb + (size_t)i * 64 * 64, 64, cmp_stats_tile(p, kt, qf, r, h, i, nrow, m, l););
        l += __shfl_xor(l, 32);
        const float invl = (l > 0.f) ? 1.0f / l : 0.f, ms = (m == -INFINITY) ? 0.f : m;
        TILE_STREAM(ntc, kcb + (size_t)i * 64 * 64, 64, vcb + (size_t)i * 64 * 64, 64, cmp_final_tile(p, od, kt, vt, qf, r, h, i, nrow, ms, invl, IMP, tl, hh, lane););
        const float gc = gate[0];
#pragma unroll
        for (int db = 0; db < 2; ++db)
#pragma unroll
            for (int i = 0; i < 16; ++i) OACC[(16 * db + i) * 64] = gc * od[db][i];
    }
    __syncthreads();
    for (int xr = 0; xr <= XTOPK; ++xr) {
        unsigned key[4], thr[4];
#pragma unroll
        for (int q4 = 0; q4 < 4; ++q4) { const int ti = 4 * wave + q4, tt = t0 + ti, cur = tt >> 6, j = lane;
            const float imp = IMP[ti * 64 + j];
            const bool forced = (j == 0) || (j == cur) || (j == cur - 1), future = j > cur;
            const unsigned bits = __float_as_uint(forced ? INFINITY : (future ? -INFINITY : imp));
            key[q4] = bits ^ ((bits & 0x80000000u) ? 0xffffffffu : 0x80000000u); thr[q4] = 0u; }
        for (int bit = 31; bit >= 0; --bit) {
#pragma unroll
            for (int q4 = 0; q4 < 4; ++q4) { const unsigned cand = thr[q4] | (1u << bit); if (__popcll(__ballot(key[q4] >= cand)) >= 16) thr[q4] = cand; } }
#pragma unroll
        for (int q4 = 0; q4 < 4; ++q4) { const int ti = 4 * wave + q4;
            unsigned long long mk = __ballot(key[q4] > thr[q4]), eq = __ballot(key[q4] == thr[q4]);
            for (int need = 16 - __popcll(mk); need > 0; --need) { const unsigned long long low = eq & (0ull - eq); mk |= low; eq ^= low; }
            if (lane == 0) { MASKS[2 * ti] = (unsigned)mk; MASKS[2 * ti + 1] = (unsigned)(mk >> 32); } }
    }
    __syncthreads();
    unsigned long long mrow, um;
    {
        mrow = (unsigned long long)MASKS[2 * tl] | ((unsigned long long)MASKS[2 * tl + 1] << 32);
        unsigned ulo = MASKS[2 * (lane & 31)], uhi = MASKS[2 * (lane & 31) + 1];
#pragma unroll
        for (int o = 1; o < 32; o <<= 1) { ulo |= __shfl_xor(ulo, o); uhi |= __shfl_xor(uhi, o); }
        um = (unsigned long long)__builtin_amdgcn_readfirstlane(ulo) | ((unsigned long long)__builtin_amdgcn_readfirstlane(uhi) << 32);
        { const int curmax = (t0 + 31) >> 6; if (curmax < 63) um &= (1ull << (curmax + 1)) - 1ull; }
        if (wave == 0) { if ((um >> lane) & 1ull) LIST[__popcll(um & ((1ull << lane) - 1ull))] = lane; }
    }
    __syncthreads();
    {
        const int nsel = __popcll(um);
        const bf16* ksr = (const bf16*)(ws + WS_KSR) + (size_t)b * SEQ * 128 + g * 64; const bf16* vs = proj + (size_t)b * SEQ * DINP + C_VS + g * 64;
        float m = 0.f, l = 0.f;
        for (int xr = 0; xr <= XSEL; ++xr) { m = 0.f; l = 0.f;
#pragma unroll
        for (int db = 0; db < 2; ++db)
#pragma unroll
            for (int i = 0; i < 16; ++i) od[db][i] = 0.f;
        TILE_STREAM(nsel, ksr + (size_t)(64 * LIST[i]) * 128, 128, vs + (size_t)(64 * LIST[i]) * DINP, DINP, { const int j = LIST[i]; sel_tile(p, od, kt, vt, qf, r, h, lane, j, ((mrow >> j) & 1ull) != 0ull, t, tmin, m, l); });
        }
        l += __shfl_xor(l, 32);
        const float sc = gate[1] * ((l > 0.f) ? 1.0f / l : 0.f);
#pragma unroll
        for (int db = 0; db < 2; ++db)
#pragma unroll
            for (int i = 0; i < 16; ++i) OACC[(16 * db + i) * 64] += sc * od[db][i];
    }
    {
        const int tj0 = (t0 >= 511) ? ((t0 - 511) >> 6) : 0, tj1 = (t0 + 31) >> 6, ntw = tj1 - tj0 + 1;
        const bf16* kwr = (const bf16*)(ws + WS_KWR) + ((size_t)b * SEQ + 64 * tj0) * 128 + g * 64; const bf16* vw = proj + ((size_t)b * SEQ + 64 * tj0) * DINP + C_VW + g * 64;
        float m = 0.f, l = 0.f;
        for (int xr = 0; xr <= XWIN; ++xr) { m = 0.f; l = 0.f;
#pragma unroll
        for (int db = 0; db < 2; ++db)
#pragma unroll
            for (int i = 0; i < 16; ++i) od[db][i] = 0.f;
        TILE_STREAM(ntw, kwr + (size_t)(64 * i) * 128, 128, vw + (size_t)(64 * i) * DINP, DINP, win_tile(p, od, kt, vt, qf, r, h, lane, 64 * (tj0 + i), t, tmin, tmax, m, l););
        }
        l += __shfl_xor(l, 32);
        const float sc = gate[2] * ((l > 0.f) ? 1.0f / l : 0.f);
#pragma unroll
        for (int db = 0; db < 2; ++db)
#pragma unroll
            for (int i = 0; i < 16; ++i) od[db][i] = OACC[(16 * db + i) * 64] + sc * od[db][i];
    }
    {
        bf16* op = (bf16*)(ws + WS_OMIX) + (size_t)tok * DM + 1024 + head * 64 + 4 * h;
#pragma unroll
        for (int db = 0; db < 2; ++db)
#pragma unroll
            for (int gq = 0; gq < 4; ++gq) { u32x2_t w; w[0] = cvtpk_s(od[db][4 * gq], od[db][4 * gq + 1]); w[1] = cvtpk_s(od[db][4 * gq + 2], od[db][4 * gq + 3]);
                *(GAS u32x2_t*)(op + 32 * db + 8 * gq) = w; }
    }
    __syncthreads();
}

constexpr int XA_KT0 = 0, XA_KT1 = 17408, XA_VT0 = 34816, XA_VT1 = 53248;
struct Stg128 { v4u k[2], v[2]; };
DI Stg128 stg_load128(const bf16* kbase, const bf16* vbase, size_t pitch, int tid) {
    Stg128 s;
#pragma unroll
    for (int j = 0; j < 2; ++j) { const int idx = tid + 512 * j, key = idx >> 4, ch = idx & 15; s.k[j] = *(const GAS v4u*)(kbase + (size_t)key * pitch + ch * 8); s.v[j] = *(const GAS v4u*)(vbase + (size_t)key * pitch + ch * 8); }
    return s;
}
DI void stg_write128(LAS unsigned char* kt, LAS unsigned char* vt, const Stg128& s, int tid) {
#pragma unroll
    for (int j = 0; j < 2; ++j) { const int idx = tid + 512 * j, key = idx >> 4, ch = idx & 15;
        *(LAS v4u*)(kt + key * 272 + ch * 16) = s.k[j];
        const unsigned w[4] = {s.v[j].x, s.v[j].y, s.v[j].z, s.v[j].w};
#pragma unroll
        for (int e = 0; e < 8; ++e) *(LAS unsigned short*)(vt + (ch * 8 + e) * 144 + key * 2) = (unsigned short)((e & 1) ? (w[e >> 1] >> 16) : (w[e >> 1] & 0xffffu)); }
}
DI void xattn_unit(const AP a, LAS unsigned char* lds, int unit, int tid, int wave, int lane) {
    unsigned char* ws = a.ws_();
    const int b = unit >> 6, head = (unit >> 4) & 3, qb = unit & 15, r = lane & 31, h = lane >> 5, tok = b * SEQ + qb * 256 + wave * 32 + r;
    const bf16* kx = (const bf16*)(ws + WS_KVX) + (size_t)b * 256 * 1024 + head * 128; const bf16* vx = kx + 512;
    bf16x8 qf[8];
    { const bf16* qp = (const bf16*)(ws + WS_QX) + (size_t)tok * 512 + head * 128 + 8 * h;
#pragma unroll
      for (int ks = 0; ks < 8; ++ks) qf[ks] = *(const GAS bf16x8*)(qp + 16 * ks); }
    float m = -INFINITY, l = 0.f; f32x16 od[4], p[2];
#pragma unroll
    for (int db = 0; db < 4; ++db)
#pragma unroll
        for (int i = 0; i < 16; ++i) od[db][i] = 0.f;
    Stg128 sg = stg_load128(kx, vx, 1024, tid);
    stg_write128(lds + XA_KT0, lds + XA_VT0, sg, tid); __syncthreads();
    for (int i = 0; i < 4; ++i) { const int cur = i & 1;
        if (i + 1 < 4) sg = stg_load128(kx + (size_t)(64 * (i + 1)) * 1024, vx + (size_t)(64 * (i + 1)) * 1024, 1024, tid);
        const LAS unsigned char* kt = lds + (cur ? XA_KT1 : XA_KT0); const LAS unsigned char* vt = lds + (cur ? XA_VT1 : XA_VT0);
#pragma unroll
        for (int kb = 0; kb < 2; ++kb) { f32x16 acc;
#pragma unroll
            for (int e = 0; e < 16; ++e) acc[e] = 0.f;
#pragma unroll
            for (int ks = 0; ks < 8; ++ks) acc = MFMA32(*(const LAS bf16x8*)(kt + (kb * 32 + r) * 272 + (16 * ks + 8 * h) * 2), qf[ks], acc);
            p[kb] = acc; }
        {
            float mt = -INFINITY;
#pragma unroll
            for (int kb = 0; kb < 2; ++kb)
#pragma unroll
                for (int e = 0; e < 16; ++e) mt = fmaxf(mt, p[kb][e]);
            mt = fmaxf(mt, __shfl_xor(mt, 32));
            const float mn = fmaxf(m, mt), alpha = __builtin_amdgcn_exp2f(m - mn); m = mn; float ls = 0.f;
#pragma unroll
            for (int kb = 0; kb < 2; ++kb)
#pragma unroll
                for (int e = 0; e < 16; ++e) { const float ev = __builtin_amdgcn_exp2f(p[kb][e] - mn); p[kb][e] = ev; ls += ev; }
            l = l * alpha + ls;
#pragma unroll
            for (int db = 0; db < 4; ++db)
#pragma unroll
                for (int e = 0; e < 16; ++e) od[db][e] *= alpha;
        }
#pragma unroll
        for (int kb = 0; kb < 2; ++kb)
#pragma unroll
            for (int s = 0; s < 2; ++s) {
                u32x4_t pw; pw[0] = cvtpk_s(p[kb][8 * s + 0], p[kb][8 * s + 1]); pw[1] = cvtpk_s(p[kb][8 * s + 2], p[kb][8 * s + 3]); pw[2] = cvtpk_s(p[kb][8 * s + 4], p[kb][8 * s + 5]); pw[3] = cvtpk_s(p[kb][8 * s + 6], p[kb][8 * s + 7]);
                const bf16x8 pf = __builtin_bit_cast(bf16x8, pw);
#pragma unroll
                for (int db = 0; db < 4; ++db) { const LAS unsigned char* vp = vt + (db * 32 + r) * 144 + (kb * 32 + 16 * s + 4 * h) * 2;
                    const u32x2_t lo = *(const LAS u32x2_t*)vp, hi = *(const LAS u32x2_t*)(vp + 16);
                    u32x4_t vw; vw[0] = lo[0]; vw[1] = lo[1]; vw[2] = hi[0]; vw[3] = hi[1];
                    od[db] = MFMA32(__builtin_bit_cast(bf16x8, vw), pf, od[db]); } }
        if (i + 1 < 4) stg_write128(lds + (cur ? XA_KT0 : XA_KT1), lds + (cur ? XA_VT0 : XA_VT1), sg, tid);
        __syncthreads();
    }
    l += __shfl_xor(l, 32);
    const float invl = 1.0f / l;
    bf16* op = (bf16*)(ws + WS_OX) + (size_t)tok * 512 + head * 128 + 4 * h;
#pragma unroll
    for (int db = 0; db < 4; ++db)
#pragma unroll
        for (int gq = 0; gq < 4; ++gq) { u32x2_t w; w[0] = cvtpk_s(od[db][4 * gq] * invl, od[db][4 * gq + 1] * invl); w[1] = cvtpk_s(od[db][4 * gq + 2] * invl, od[db][4 * gq + 3] * invl);
            *(GAS u32x2_t*)(op + 32 * db + 8 * gq) = w; }
}
DI void phase_final_norm(const AP a, int gw, int NGW, int lane) {
    const float* ssq = (const float*)(a.ws_() + WS_SSQ); const float* w = a.in_(27);
    for (int m = gw; m < NTOK; m += NGW) {
        const f32x4* sp = (const f32x4*)(ssq + (size_t)m * 32); float s = 0.f;
#pragma unroll
        for (int j = 0; j < 8; ++j) { const f32x4 v = sp[j]; s += (v[0] + v[1]) + (v[2] + v[3]); }
        const float rs = __builtin_amdgcn_rsqf(s * (1.0f / 2048.0f) + 1e-6f);
        GAS f32x4* xr = (GAS f32x4*)(a.out_() + (size_t)m * DM) + lane;
#pragma unroll
        for (int j = 0; j < 8; ++j) { const f32x4 wv = ((const GAS f32x4*)w)[lane + 64 * j]; xr[64 * j] = xr[64 * j] * rs * wv; }
    }
}

__global__ void __launch_bounds__(NWAVES * 64, 2) mega(Args args) {
    extern __shared__ __attribute__((aligned(16))) unsigned char lds_raw[];
    LAS unsigned char* lds = (LAS unsigned char*)lds_raw;
    volatile LAS unsigned* MISC = (volatile LAS unsigned*)(lds + MISC_OFF);
    const int tid = threadIdx.x, lane = tid & 63, wave = __builtin_amdgcn_readfirstlane(tid >> 6);
    const int G = gridDim.x, bid = blockIdx.x;
    const int gw = bid * NWAVES + wave, NGW = G * NWAVES;
    for (int u = tid; u < (LDS_BYTES - LDSCTL_OFF) / 4; u += NWAVES * 64) ((LAS unsigned*)(lds + LDSCTL_OFF))[u] = 0u;
    __syncthreads();
    const int lo = args.ph_lo, hi = args.ph_hi;
    XcdBarrier bar; bar.bar = (unsigned*)(args.ws + WS_CTL) + CW_BAR; bar.x = 0; bar.st = nullptr;
    if (hi - lo > 1) bar = xcd_barrier_post((unsigned*)(args.ws + WS_CTL) + CW_BAR, MISC + 8);
#ifndef REP_PHASE
#define REP_PHASE -1
#endif
#define IN(k) (lo <= (k) && (k) < hi)
#define NREP(k) (IN(k) ? (((k) == REP_PHASE) ? 2 : 1) : 0)
#define SEAM(k) do { if (IN(k) && IN((k) + 1)) xcd_barrier(bar); } while (0)
#define GEMM_RUN(EPI, g, S, E) pg8::gemm_phase<EPI, pg8::StaticOrder, true, true>(lds + RING_OFF, g, S, E)

    for (int rep_ = 0; rep_ < NREP(0); ++rep_) { if (rep_) xcd_barrier(bar); const AP a = make_ap(); phase_prologue(a, lds, gw, NGW, wave, lane); }
    SEAM(0);
    for (int rep_ = 0; rep_ < NREP(1); ++rep_) { if (rep_) xcd_barrier(bar);
        const AP a = make_ap(); unsigned char* ws = a.ws_();
        pg8::Gemm g{(const bf16*)(ws + WS_XB), (const bf16*)(ws + WS_WGU), NTOK, 2 * FF, DM}; pg8::StaticOrder S; S.init(NTOK, 2 * FF, G, bid);
        pg8::EpiSwiglu E{(bf16*)(ws + WS_ACT), FF, (const float*)(ws + WS_SSQ)};
        GEMM_RUN(pg8::EpiSwiglu, g, S, E);
    }
#if defined(XGEMM)
    if (IN(1)) { xcd_barrier(bar);
        const AP a = make_ap(); unsigned char* ws = a.ws_();
        pg8::Gemm g{(const bf16*)(ws + WS_XB), (const bf16*)(ws + WS_WGU), NTOK, 2 * FF, DM}; pg8::StaticOrder S; S.init(NTOK, 2 * FF, G, bid);
        pg8::EpiNull E{(float*)(ws + WS_END)};
        GEMM_RUN(pg8::EpiNull, g, S, E);
    }
#endif
    SEAM(1);
    for (int rep_ = 0; rep_ < NREP(2); ++rep_) { if (rep_) xcd_barrier(bar);
        const AP a = make_ap(); unsigned char* ws = a.ws_();
        pg8::Gemm g{(const bf16*)(ws + WS_ACT), (const bf16*)(ws + WS_WD), NTOK, DM, FF}; pg8::StaticOrder S; S.init(NTOK, DM, G, bid);
        pg8::EpiResid E{a.in_(0), a.out_(), (bf16*)(ws + WS_XB), (float*)(ws + WS_SSQ), 0.5f};
        GEMM_RUN(pg8::EpiResid, g, S, E);
    }
    SEAM(2);
    for (int rep_ = 0; rep_ < NREP(3); ++rep_) { if (rep_) xcd_barrier(bar);
        const AP a = make_ap(); unsigned char* ws = a.ws_();
        pg8::Gemm g{(const bf16*)(ws + WS_XB), (const bf16*)(ws + WS_WIN), NTOK, DINP, DM}; pg8::StaticOrder S; S.init(NTOK, DINP, G, bid);
        pg8::EpiScaleBf16 E{(bf16*)(ws + WS_PROJ), DINP, (const float*)(ws + WS_SSQ), 1.0f};
        GEMM_RUN(pg8::EpiScaleBf16, g, S, E);
    }
    SEAM(3);
    for (int rep_ = 0; rep_ < NREP(4); ++rep_) { if (rep_) xcd_barrier(bar); const AP a = make_ap(); phase_postproj(a, gw, NGW, lane); for (int u = bid; u < 1024; u += G) hgrn_a_unit(a, lds, u, tid, wave, lane); }
    SEAM(4);
    for (int rep_ = 0; rep_ < NREP(5); ++rep_) { if (rep_) xcd_barrier(bar);
        if (bid < 8) {
            { const AP a = make_ap(); unsigned char* ws = a.ws_();
              pg8::Gemm g{(const bf16*)(ws + WS_CA), (const bf16*)(ws + WS_W1T), 1024, 256, 2048}; pg8::StaticOrder S; S.init(1024, 256, G, bid);
              pg8::EpiSiluBf16 E{(bf16*)(ws + WS_HID), 256};
              GEMM_RUN(pg8::EpiSiluBf16, g, S, E); }
            { const AP a = make_ap(); unsigned char* ws = a.ws_();
              pg8::Gemm g{(const bf16*)(ws + WS_CA) + (size_t)1024 * 2048, (const bf16*)(ws + WS_W1T) + (size_t)256 * 2048, 1024, 256, 2048}; pg8::StaticOrder S; S.init(1024, 256, G, (bid + G - 4) % G);
              pg8::EpiSiluBf16 E{(bf16*)(ws + WS_HID) + (size_t)1024 * 256, 256};
              GEMM_RUN(pg8::EpiSiluBf16, g, S, E); }
        } else { const AP a = make_ap(); hgrn_b_scan(a, (bid - 8) * (NWAVES * 64) + tid, (G - 8) * (NWAVES * 64)); }
    }
    SEAM(5);
    for (int rep_ = 0; rep_ < NREP(6); ++rep_) { if (rep_) xcd_barrier(bar); const AP a = make_ap(); phase_cmp_out(a, gw, NGW, lane); for (int u = bid; u < 1024; u += G) hgrn_c_unit(a, lds, u, tid, wave, lane); }
    SEAM(6);
    for (int rep_ = 0; rep_ < NREP(7); ++rep_) { if (rep_) xcd_barrier(bar); const AP a = make_ap(); for (int u = bid; u < 512; u += G) { const int k = u / G, v = u % G; nsa_unit(a, lds, (k & 1) ? (u - v + (G - 1 - v)) : u, tid, wave, lane); } }
    SEAM(7);
    for (int rep_ = 0; rep_ < NREP(8); ++rep_) { if (rep_) xcd_barrier(bar);
        const AP a = make_ap(); unsigned char* ws = a.ws_();
        pg8::Gemm g{(const bf16*)(ws + WS_OMIX), (const bf16*)(ws + WS_WOUT), NTOK, DM, DM}; pg8::StaticOrder S; S.init(NTOK, DM, G, bid);
        pg8::EpiResid E{a.out_(), a.out_(), (bf16*)(ws + WS_XB), (float*)(ws + WS_SSQ), 1.0f};
        GEMM_RUN(pg8::EpiResid, g, S, E);
    }
    SEAM(8);
    for (int rep_ = 0; rep_ < NREP(9); ++rep_) { if (rep_) xcd_barrier(bar);
        { const AP a = make_ap(); unsigned char* ws = a.ws_();
          pg8::Gemm g{(const bf16*)(ws + WS_XB), (const bf16*)(ws + WS_WQ), NTOK, 512, DM}; pg8::StaticOrder S; S.init(NTOK, 512, G, bid);
          pg8::EpiScaleBf16 E{(bf16*)(ws + WS_QX), 512, (const float*)(ws + WS_SSQ), 0.08838834764831845f * LOG2E};
          GEMM_RUN(pg8::EpiScaleBf16, g, S, E); }
        { const AP a = make_ap(); unsigned char* ws = a.ws_();
          pg8::Gemm g{(const bf16*)(ws + WS_MEMN), (const bf16*)(ws + WS_WKV), 512, 1024, DM}; pg8::StaticOrder S; S.init(512, 1024, G, (bid + G - 64) % G);
          pg8::EpiScaleBf16 E{(bf16*)(ws + WS_KVX), 1024, nullptr, 1.0f};
          GEMM_RUN(pg8::EpiScaleBf16, g, S, E); }
    }
    SEAM(9);
    for (int rep_ = 0; rep_ < NREP(10); ++rep_) { if (rep_) xcd_barrier(bar);
        const AP a = make_ap();
        for (int u = bid; u < 128; u += G) xattn_unit(a, lds, u, tid, wave, lane);
        phase_ffn2_weights(a, lds, gw, NGW, wave, lane);
    }
    SEAM(10);
    for (int rep_ = 0; rep_ < NREP(11); ++rep_) { if (rep_) xcd_barrier(bar);
        const AP a = make_ap(); unsigned char* ws = a.ws_();
        pg8::Gemm g{(const bf16*)(ws + WS_OX), (const bf16*)(ws + WS_WO), NTOK, DM, 512}; pg8::StaticOrder S; S.init(NTOK, DM, G, bid);
        pg8::EpiResid E{a.out_(), a.out_(), (bf16*)(ws + WS_XB), (float*)(ws + WS_SSQ), 1.0f};
        GEMM_RUN(pg8::EpiResid, g, S, E);
    }
    SEAM(11);
    for (int rep_ = 0; rep_ < NREP(12); ++rep_) { if (rep_) xcd_barrier(bar);
        const AP a = make_ap(); unsigned char* ws = a.ws_();
        pg8::Gemm g{(const bf16*)(ws + WS_XB), (const bf16*)(ws + WS_WGU), NTOK, 2 * FF, DM}; pg8::StaticOrder S; S.init(NTOK, 2 * FF, G, bid);
        pg8::EpiSwiglu E{(bf16*)(ws + WS_ACT), FF, (const float*)(ws + WS_SSQ)};
        GEMM_RUN(pg8::EpiSwiglu, g, S, E);
    }
    SEAM(12);
    for (int rep_ = 0; rep_ < NREP(13); ++rep_) { if (rep_) xcd_barrier(bar);
        const AP a = make_ap(); unsigned char* ws = a.ws_();
        pg8::Gemm g{(const bf16*)(ws + WS_ACT), (const bf16*)(ws + WS_WD), NTOK, DM, FF}; pg8::StaticOrder S; S.init(NTOK, DM, G, bid);
        pg8::EpiResid E{a.out_(), a.out_(), nullptr, (float*)(ws + WS_SSQ), 0.5f};
        GEMM_RUN(pg8::EpiResid, g, S, E);
    }
    SEAM(13);
    for (int rep_ = 0; rep_ < NREP(14); ++rep_) { if (rep_) xcd_barrier(bar); const AP a = make_ap(); phase_final_norm(a, gw, NGW, lane); }
#undef IN
#undef SEAM
#undef GEMM_RUN
}

extern "C" void kernel_launch(void* const* d_in, const int* in_sizes, int n_in, void* d_out, int out_size, void* d_ws, size_t ws_size, hipStream_t stream) {
    static int grid = 0;
    if (grid == 0) {
        if (n_in != 28 || in_sizes[0] != NTOK * DM || out_size != NTOK * DM || ws_size < WS_END) { fprintf(stderr, "kernel_launch: unexpected shapes / workspace (n_in %d, ws %zu); nothing launched\n", n_in, ws_size); grid = -1; return; }
        int dev = 0, cus = 0;
        if (hipGetDevice(&dev) != hipSuccess || hipDeviceGetAttribute(&cus, hipDeviceAttributeMultiprocessorCount, dev) != hipSuccess) { grid = -1; return; }
        if (hipFuncSetAttribute((const void*)mega, hipFuncAttributeMaxDynamicSharedMemorySize, LDS_BYTES) != hipSuccess) { fprintf(stderr, "kernel_launch: hipFuncSetAttribute failed\n"); grid = -1; return; }
        (void)hipGetLastError();
        grid = cus;
    }
    if (grid < 0) return;
    if (hipMemsetAsync((char*)d_ws + WS_CTL, 0, CTL_ZERO_BYTES, stream) != hipSuccess) return;
    Args a{};
    for (int i = 0; i < 28; ++i) a.in[i] = (const float*)d_in[i];
    a.out = (float*)d_out; a.ws = (unsigned char*)d_ws;
#if MK_ONE_LAUNCH
    a.ph_lo = 0; a.ph_hi = NPH;
    hipLaunchKernelGGL(mega, dim3(grid), dim3(NWAVES * 64), LDS_BYTES, stream, a);
#else
    for (int k = 0; k < NPH; ++k) { a.ph_lo = k; a.ph_hi = k + 1; hipLaunchKernelGGL(mega, dim3(grid), dim3(NWAVES * 64), LDS_BYTES, stream, a); }
#endif
}
```
